# Optimizing an MI355X kernel written in HIP

```python
import math
import jax, jax.numpy as jnp
from jax import lax
import numpy as np

D_MODEL = 2048
BATCH = 4
SEQ = 4096
DEPTH = 1

M_HEADS = 4
M_DH = D_MODEL // M_HEADS
M_WIDTH = M_HEADS * M_DH
M_CHUNK = 64
A_HEADS = 16
A_KV_HEADS = 4
A_GROUP = A_HEADS // A_KV_HEADS
A_DH = D_MODEL // A_HEADS
A_WIDTH = A_HEADS * A_DH
WINDOW = 128
A_BLOCK = WINDOW
REL_BUCKETS = 32
REL_MAX_DIST = 128
PEER_HEADS = 8
PEER_NKEYS = 128
PEER_TOPK = 16
PEER_QDIM = 256
PEER_EXPERTS = PEER_NKEYS * PEER_NKEYS
PEER_TOKEN_BLOCK = 128
EPS = 1e-6

IN_SPLITS = (M_WIDTH, M_WIDTH, M_WIDTH, M_WIDTH, 4 * M_HEADS,
             A_WIDTH, A_KV_HEADS * A_DH, A_KV_HEADS * A_DH, D_MODEL, D_MODEL)
IN_COLS = sum(IN_SPLITS)
IN_OFFSETS = tuple(int(v) for v in np.cumsum(IN_SPLITS)[:-1])

kernel_name = "hybrid_mlstm_swa_peer_block"


def rmsnorm(x, g):
    xf = x.astype(jnp.float32)
    y = xf * lax.rsqrt(jnp.mean(xf * xf, axis=-1, keepdims=True) + EPS)
    return (y * g.astype(jnp.float32)).astype(x.dtype)


def mlstm_chunkwise(q, k, v, log_i, log_f):
    B, H, S, dk = q.shape
    dv = v.shape[-1]
    nc = S // M_CHUNK

    def to_chunks(a):
        a = a.reshape((B, H, nc, M_CHUNK) + a.shape[3:])
        return jnp.moveaxis(a, 2, 0)

    causal_in_chunk = jnp.tril(jnp.ones((M_CHUNK, M_CHUNK), dtype=bool))

    def step(carry, inp):
        C, n, m = carry
        q_, k_, v_, li, lf = inp
        b = jnp.cumsum(lf, axis=-1)
        dmat = b[..., :, None] - b[..., None, :] + li[..., None, :]
        dmat = jnp.where(causal_in_chunk, dmat, -jnp.inf)
        inter = b + m[..., None]
        m_row = jnp.maximum(inter, jnp.max(dmat, axis=-1))
        w_inter = jnp.exp(inter - m_row)
        s = jnp.einsum('bhld,bhsd->bhls', q_, k_) * jnp.exp(dmat - m_row[..., None])
        num = (w_inter[..., None] * jnp.einsum('bhld,bhdv->bhlv', q_, C)
               + jnp.einsum('bhls,bhsv->bhlv', s, v_))
        den = w_inter * jnp.einsum('bhld,bhd->bhl', q_, n) + jnp.sum(s, axis=-1)
        h = num / jnp.maximum(jnp.abs(den), jnp.exp(-m_row))[..., None]
        b_last = b[..., -1]
        g = b_last[..., None] - b + li
        m_new = jnp.maximum(b_last + m, jnp.max(g, axis=-1))
        decay = jnp.exp(b_last + m - m_new)
        wk = jnp.exp(g - m_new[..., None])
        kw = k_ * wk[..., None]
        C_new = decay[..., None, None] * C + jnp.einsum('bhld,bhlv->bhdv', kw, v_)
        n_new = decay[..., None] * n + jnp.sum(kw, axis=2)
        return (C_new, n_new, m_new), h

    init = (jnp.zeros((B, H, dk, dv), jnp.float32),
            jnp.zeros((B, H, dk), jnp.float32),
            jnp.zeros((B, H), jnp.float32))
    _, hs = lax.scan(step, init, (to_chunks(q), to_chunks(k), to_chunks(v),
                                  to_chunks(log_i), to_chunks(log_f)))
    return jnp.moveaxis(hs, 0, 2).reshape(B, H, S, dv)


def t5_bucket(rel):
    half = REL_BUCKETS // 2
    max_exact = half // 2
    ret = jnp.where(rel > 0, half, 0)
    n = jnp.abs(rel)
    nf = jnp.maximum(n, 1).astype(jnp.float32)
    large = max_exact + (jnp.log(nf / max_exact) / math.log(REL_MAX_DIST / max_exact)
                         * (half - max_exact)).astype(jnp.int32)
    large = jnp.minimum(large, half - 1)
    return ret + jnp.where(n < max_exact, n, large)


def banded_window_attention(q, k, v, sink, rel_bias):
    B, S = q.shape[0], q.shape[1]
    nb = S // A_BLOCK
    qb = q.reshape(B, nb, A_BLOCK, A_KV_HEADS, A_GROUP, A_DH)
    pad = ((0, 0), (A_BLOCK, A_BLOCK), (0, 0), (0, 0))

    def band(t):
        tp = jnp.pad(t, pad).reshape(B, nb + 2, A_BLOCK, A_KV_HEADS, A_DH)
        return jnp.concatenate([tp[:, :-2], tp[:, 1:-1], tp[:, 2:]], axis=2)

    k_band, v_band = band(k), band(v)
    q_local = jnp.arange(A_BLOCK)
    k_local = jnp.arange(3 * A_BLOCK) - A_BLOCK
    rel = k_local[None, :] - q_local[:, None]
    in_window = jnp.abs(rel) <= WINDOW
    bias = rel_bias.astype(jnp.float32)[t5_bucket(rel)]
    bias = bias.transpose(2, 0, 1).reshape(A_KV_HEADS, A_GROUP, A_BLOCK, 3 * A_BLOCK)
    k_pos = jnp.arange(nb)[:, None] * A_BLOCK + k_local[None, :]
    valid = (k_pos >= 0) & (k_pos < S)
    mask = in_window[None] & valid[:, None, :]
    sink_f = sink.astype(jnp.float32).reshape(A_KV_HEADS, A_GROUP, 1, 1)

    def block_fn(args):
        qb_, kb_, vb_, mb_ = args
        s = jnp.einsum('bqhgd,bkhd->bhgqk', qb_, kb_).astype(jnp.float32) + bias
        s = jnp.where(mb_, s, -jnp.inf)
        sink_col = jnp.broadcast_to(sink_f, s.shape[:-1] + (1,))
        p = jax.nn.softmax(jnp.concatenate([s, sink_col], axis=-1), axis=-1)[..., :-1]
        return jnp.einsum('bhgqk,bkhd->bqhgd', p.astype(vb_.dtype), vb_)

    out = lax.map(block_fn, (jnp.moveaxis(qb, 1, 0), jnp.moveaxis(k_band, 1, 0),
                             jnp.moveaxis(v_band, 1, 0), mask))
    return jnp.moveaxis(out, 0, 1).reshape(B, S, A_WIDTH)


def peer_ffn(xt, peer_wq, peer_keys, peer_u, peer_v):
    T = xt.shape[0]
    K = PEER_TOPK
    pq = (xt @ peer_wq).reshape(T, PEER_HEADS, 2, PEER_QDIM // 2)
    sub = jnp.einsum('thpd,hpnd->thpn', pq, peer_keys).astype(jnp.float32)
    sv, si = lax.top_k(sub, K)
    cand = (sv[:, :, 0, :, None] + sv[:, :, 1, None, :]).reshape(T, PEER_HEADS, K * K)
    cv, ci = lax.top_k(cand, K)
    e1 = jnp.take_along_axis(si[:, :, 0], ci // K, axis=-1)
    e2 = jnp.take_along_axis(si[:, :, 1], ci % K, axis=-1)
    experts = (e1 * PEER_NKEYS + e2).reshape(T, PEER_HEADS * K)
    gates = jax.nn.softmax(cv, axis=-1).reshape(T, PEER_HEADS * K).astype(xt.dtype)
    nblk = T // PEER_TOKEN_BLOCK

    def expert_block(args):
        xb, eb, gb = args
        u = peer_u[eb]
        act = jax.nn.gelu(jnp.einsum('tkd,td->tk', u, xb), approximate=False) * gb
        return jnp.einsum('tk,tkd->td', act, peer_v[eb])

    out = lax.map(expert_block, (xt.reshape(nblk, PEER_TOKEN_BLOCK, -1),
                                 experts.reshape(nblk, PEER_TOKEN_BLOCK, -1),
                                 gates.reshape(nblk, PEER_TOKEN_BLOCK, -1)))
    return out.reshape(T, -1)


def setup_inputs(seed: int = 0) -> dict:
    key = jax.random.key(seed)
    ks = jax.random.split(key, 20)
    nrm = lambda k, shape, scale: jax.random.normal(k, shape, jnp.float32) * scale
    x = nrm(ks[0], (BATCH, SEQ, D_MODEL), 1.0)
    norm1_g = 1.0 + nrm(ks[1], (D_MODEL,), 0.05)
    w_in = nrm(ks[2], (D_MODEL, IN_COLS), D_MODEL ** -0.5)
    ib = nrm(ks[3], (2, M_HEADS), 0.1)
    fb = jnp.linspace(3.0, 6.0, M_HEADS, dtype=jnp.float32)[None, :] + nrm(ks[4], (2, M_HEADS), 0.1)
    mlstm_gate_b = jnp.stack([ib, fb], axis=1)
    mlstm_norm_g = 1.0 + nrm(ks[5], (M_HEADS, M_DH), 0.05)
    w_m_proj = nrm(ks[6], (M_WIDTH, D_MODEL), M_WIDTH ** -0.5)
    attn_q_norm_g = 1.0 + nrm(ks[7], (A_DH,), 0.05)
    attn_k_norm_g = 1.0 + nrm(ks[8], (A_DH,), 0.05)
    attn_sink = nrm(ks[9], (A_HEADS,), 0.5)
    rel_bias = nrm(ks[10], (REL_BUCKETS, A_HEADS), 0.5)
    w_a_proj = nrm(ks[11], (A_WIDTH, D_MODEL), A_WIDTH ** -0.5)
    w_out = nrm(ks[12], (D_MODEL, D_MODEL), D_MODEL ** -0.5)
    norm2_g = 1.0 + nrm(ks[13], (D_MODEL,), 0.05)
    peer_wq = nrm(ks[14], (D_MODEL, PEER_HEADS * PEER_QDIM), D_MODEL ** -0.5)
    peer_keys = nrm(ks[15], (PEER_HEADS, 2, PEER_NKEYS, PEER_QDIM // 2), (PEER_QDIM // 2) ** -0.5)
    peer_u = nrm(ks[16], (PEER_EXPERTS, D_MODEL), D_MODEL ** -0.5)
    peer_v = nrm(ks[17], (PEER_EXPERTS, D_MODEL), PEER_HEADS ** -0.5)
    return {"x": x, "norm1_g": norm1_g, "w_in": w_in, "mlstm_gate_b": mlstm_gate_b,
            "mlstm_norm_g": mlstm_norm_g, "w_m_proj": w_m_proj,
            "attn_q_norm_g": attn_q_norm_g, "attn_k_norm_g": attn_k_norm_g,
            "attn_sink": attn_sink, "rel_bias": rel_bias, "w_a_proj": w_a_proj,
            "w_out": w_out, "norm2_g": norm2_g, "peer_wq": peer_wq,
            "peer_keys": peer_keys, "peer_u": peer_u, "peer_v": peer_v}


def reference(x, norm1_g, w_in, mlstm_gate_b, mlstm_norm_g, w_m_proj,
              attn_q_norm_g, attn_k_norm_g, attn_sink, rel_bias, w_a_proj,
              w_out, norm2_g, peer_wq, peer_keys, peer_u, peer_v):
    B, S, D = x.shape
    f32 = jnp.float32
    for _layer in range(DEPTH):
        xn = rmsnorm(x, norm1_g)
        proj = xn @ w_in
        mq, mk, mv, mo, mg, aq, ak, av, gm, ga = jnp.split(proj, IN_OFFSETS, axis=-1)

        heads_first = lambda t: t.reshape(B, S, M_HEADS, M_DH).transpose(0, 2, 1, 3).astype(f32)
        q_m = heads_first(mq)
        k_m = heads_first(mk) * (M_DH ** -0.5)
        v_m = heads_first(mv)
        gates = (mg.reshape(B, S, 2, 2, M_HEADS).astype(f32) + mlstm_gate_b.astype(f32))
        gates = gates.transpose(2, 3, 0, 4, 1)
        h_fwd = mlstm_chunkwise(q_m, k_m, v_m, gates[0, 0], jax.nn.log_sigmoid(gates[0, 1]))
        flip = lambda t: jnp.flip(t, axis=2)
        h_bwd = flip(mlstm_chunkwise(flip(q_m), flip(k_m), flip(v_m),
                                     flip(gates[1, 0]), flip(jax.nn.log_sigmoid(gates[1, 1]))))
        h_m = (h_fwd + h_bwd).transpose(0, 2, 1, 3)
        h_m = h_m * lax.rsqrt(jnp.mean(h_m * h_m, axis=-1, keepdims=True) + EPS) * mlstm_norm_g.astype(f32)
        h_m = (h_m.reshape(B, S, M_WIDTH) * jax.nn.sigmoid(mo.astype(f32))).astype(x.dtype)
        br_m = h_m @ w_m_proj

        q_a = rmsnorm(aq.reshape(B, S, A_HEADS, A_DH), attn_q_norm_g) * (A_DH ** -0.5)
        k_a = rmsnorm(ak.reshape(B, S, A_KV_HEADS, A_DH), attn_k_norm_g)
        v_a = av.reshape(B, S, A_KV_HEADS, A_DH)
        h_a = banded_window_attention(q_a, k_a, v_a, attn_sink, rel_bias)
        br_a = h_a @ w_a_proj

        merged = (jax.nn.sigmoid(gm.astype(f32)) * br_m.astype(f32)
                  + jax.nn.sigmoid(ga.astype(f32)) * br_a.astype(f32)).astype(x.dtype)
        x = x + merged @ w_out

        xn2 = rmsnorm(x, norm2_g).reshape(B * S, D)
        x = x + peer_ffn(xn2, peer_wq, peer_keys, peer_u, peer_v).reshape(B, S, D)
    return x
```

```cpp
#include <hip/hip_runtime.h>
#include <cstdio>
namespace pg8 {
#define PG8_LAS __attribute__((address_space(3)))
typedef unsigned short bf16_t;
typedef short bf16x8 __attribute__((ext_vector_type(8)));
typedef float f32x4 __attribute__((ext_vector_type(4)));
typedef unsigned u32x4 __attribute__((ext_vector_type(4)));
constexpr int BM = 256, BK = 64, HALF = 128, HTB = HALF * BK * 2  , STAGE_BYTES = 8 * HTB, NXCD = 8, WGM = 8;

__host__ __device__ __forceinline__ int lds_byte(int r, int c) { const int st = (r >> 4) * 2 + (c >> 5), rr = r & 15, cc = c & 31, ob = rr * 64 + cc * 2; return st * 1024 + (ob ^ (((ob >> 9) & 1) << 5)); }
__host__ __device__ __forceinline__ void stage_rc(int b, int& R, int& C) { const int st = b / 1024, sb = b % 1024, swz = sb ^ (((sb >> 9) & 1) << 5); R = (st >> 1) * 16 + swz / 64; C = (st & 1) * 32 + (swz % 64) / 2; }
__host__ __device__ __forceinline__ int perm32(int rho) { const int n = rho >> 4, i = rho & 15; return 8 * (i >> 2) + 4 * n + (i & 3); }

struct Unit { int pm, pn; };
struct Gemm { const bf16_t* A; const bf16_t* Bt; int M, N, K; };

struct StaticOrder {
    int nM, nN, nwg, G, c;
    __host__ __device__ void init(int M, int N, int G_, int c_) { nM = M / BM; nN = N / BM; nwg = nM * nN; G = G_; c = c_; }
    __host__ __device__ bool next(int i, Unit& u) const {
        const long L = (long)i * G + c; if (L >= nwg) return false;
        int wgid = (int)L; { const int q = nwg / NXCD, r = nwg % NXCD, xcd = wgid % NXCD, off = wgid / NXCD; wgid = (xcd < r ? xcd * (q + 1) : r * (q + 1) + (xcd - r) * q) + off; }
        const int nig = WGM * nN, gid = wgid / nig, fm = gid * WGM, gsz = (nM - fm) < WGM ? (nM - fm) : WGM;
        u.pm = fm + ((wgid % nig) % gsz); u.pn = (wgid % nig) / gsz; return true;
    }
    __device__ __forceinline__ void a_ready(const Unit&) const {}
    __device__ __forceinline__ void done(const Unit&) const {}
};
struct CountedOrder : StaticOrder {
    const unsigned* ready; unsigned need; unsigned* tmo;
    __device__ __forceinline__ void a_ready(const Unit& u) const {
        if (threadIdx.x < 64) {
            const unsigned long long t0 = __builtin_amdgcn_s_memrealtime(); unsigned polls = 0;
            while ((unsigned)__builtin_amdgcn_readfirstlane(__hip_atomic_load(ready + 64 * u.pm, __ATOMIC_RELAXED, __HIP_MEMORY_SCOPE_AGENT)) < need) {
                if ((++polls & 255u) == 0u && __builtin_amdgcn_readfirstlane(__hip_atomic_load(tmo, __ATOMIC_RELAXED, __HIP_MEMORY_SCOPE_AGENT)) != 0u) break;
                if (__builtin_amdgcn_s_memrealtime() - t0 > 2000000ull) {
                    if (threadIdx.x == 0) { unsigned expect = 0u; __hip_atomic_compare_exchange_strong(tmo + 1, &expect, 0x600u | (unsigned)(u.pm & 0xff), __ATOMIC_RELAXED, __ATOMIC_RELAXED, __HIP_MEMORY_SCOPE_AGENT); __hip_atomic_store(tmo, 1u, __ATOMIC_RELAXED, __HIP_MEMORY_SCOPE_AGENT); }
                    break; }
                __builtin_amdgcn_s_sleep(2); }
            __builtin_amdgcn_fence(__ATOMIC_ACQUIRE, "agent");
            asm volatile("s_waitcnt vmcnt(0)" ::: "memory");
        }
#if !defined(BROKEN_HOOK_NO_BARRIER)
        asm volatile("" ::: "memory"); __builtin_amdgcn_s_barrier(); asm volatile("" ::: "memory");
#endif
    }
};

__device__ __forceinline__ unsigned cvt_pk_bf16(float lo, float hi) { unsigned r; asm volatile("v_cvt_pk_bf16_f32 %0, %1, %2" : "=v"(r) : "v"(lo), "v"(hi)); return r; }
typedef float f32x2 __attribute__((ext_vector_type(2)));
__device__ __forceinline__ f32x2 gelu_pk(f32x2 v) {
    const f32x2 av = __builtin_elementwise_abs(v), d = av * 0.2316418882f + 1.0f;
    f32x2 t; t.x = __builtin_amdgcn_rcpf(d.x); t.y = __builtin_amdgcn_rcpf(d.y);
    f32x2 q = t * 0.5307027145f + (-0.7265760135f); q = q * t + 0.7107068705f; q = q * t + (-0.142248368f); q = q * t + 0.127414796f; q = q * t;
    const f32x2 s = (v * v) * (-0.72134752044f);
    f32x2 e; e.x = __builtin_amdgcn_exp2f(s.x); e.y = __builtin_amdgcn_exp2f(s.y);
    const f32x2 m = v * (q * e), r = v - m;
    f32x2 o; o.x = v.x < 0.f ? m.x : r.x; o.y = v.y < 0.f ? m.y : r.y; return o;
}

template <class Epi, class Sched, bool STAMP = false>
__device__ __forceinline__ void gemm_phase(PG8_LAS unsigned char* lds, const Gemm g, const Sched& S, const Epi& E, unsigned long long* stamps) {
    const int tid = threadIdx.x, wid = __builtin_amdgcn_readfirstlane(tid >> 6), lane = tid & 63, wr = wid >> 2, wc = wid & 3, fr = lane & 15, fq = lane >> 4;
    const int K = g.K, nt = K / BK;
    int ts_lo = 0, ts_hi = 0, nts = 0; const unsigned long long rt_entry = STAMP ? (unsigned long long)wall_clock64() : 0ull;
#define PG8_STAMP() do { if (STAMP && wid == 0 && nts < 64) { const unsigned long long _c = (unsigned long long)clock64(); \
        ts_lo = (lane == nts) ? (int)(unsigned)_c : ts_lo; ts_hi = (lane == nts) ? (int)(unsigned)(_c >> 32) : ts_hi; ++nts; } } while (0)
    PG8_STAMP();
    unsigned voffA[2], voffB[2];
#pragma unroll
    for (int i = 0; i < 2; ++i) { int R, C; stage_rc(tid * 16 + i * 8192, R, C); const int Rb = Epi::PERM ? ((R & ~31) + perm32(R & 31)) : R;
        voffA[i] = (unsigned)(R * K + C) * 2u; voffB[i] = (unsigned)(Rb * K + C) * 2u; }
    const size_t kstep = (size_t)(BK * 2);
    const size_t hstep = (size_t)HALF * K * 2;
    const size_t tstep = 2 * hstep;
    const unsigned ldsw = (unsigned)wid * 1024u;
    const int aoff = lds_byte(wr * 64 + fr, fq * 8), boff = lds_byte(wc * 32 + fr, fq * 8);
#define PG8_SA(b, h) (((b) * 2 + (h)) * HTB)
#define PG8_SB(b, h) ((4 + (b) * 2 + (h)) * HTB)
#define PG8_STAGE(bufoff, gbase, voff) do { _Pragma("unroll") for (int _i = 0; _i < 2; ++_i) \
        __builtin_amdgcn_global_load_lds((const unsigned*)((const char*)(gbase) + (voff)[_i]), (PG8_LAS unsigned*)(lds + (bufoff) + ldsw + _i * 8192), 16, 0, 0); } while (0)
#define PG8_LDA(dst, b, h) do { _Pragma("unroll") for (int m = 0; m < 4; ++m) _Pragma("unroll") for (int k = 0; k < 2; ++k) dst[m][k] = *(const PG8_LAS bf16x8*)(lds + PG8_SA(b, h) + aoff + m * 2048 + k * 1024); } while (0)
#define PG8_LDB(dst, b, h) do { _Pragma("unroll") for (int n = 0; n < 2; ++n) _Pragma("unroll") for (int k = 0; k < 2; ++k) dst[n][k] = *(const PG8_LAS bf16x8*)(lds + PG8_SB(b, h) + boff + n * 2048 + k * 1024); } while (0)
#define PG8_MMA(ai, bj, At, Bt) do { __builtin_amdgcn_s_setprio(1); _Pragma("unroll") for (int m = 0; m < 4; ++m) _Pragma("unroll") for (int n = 0; n < 2; ++n) _Pragma("unroll") for (int k = 0; k < 2; ++k) \
        acc[ai][bj][m][n] = __builtin_amdgcn_mfma_f32_16x16x32_bf16(Bt[n][k], At[m][k], acc[ai][bj][m][n], 0, 0, 0); __builtin_amdgcn_s_setprio(0); } while (0)
#define PG8_WAIT_V(n) asm volatile("s_waitcnt vmcnt(" #n ")" ::: "memory")
#define PG8_WAIT_L(n) asm volatile("s_waitcnt lgkmcnt(" #n ")" ::: "memory")
#define PG8_BAR __builtin_amdgcn_s_barrier()
#define PG8_SCHED __builtin_amdgcn_sched_barrier(0)
    Unit cur, nxt; int ui = 0;
    if (!S.next(0, cur)) return;
    f32x4 acc[2][2][4][2];
#pragma unroll
    for (int a = 0; a < 2; ++a)
#pragma unroll
        for (int b = 0; b < 2; ++b)
#pragma unroll
            for (int m = 0; m < 4; ++m)
#pragma unroll
                for (int n = 0; n < 2; ++n) acc[a][b][m][n] = (f32x4){0.f, 0.f, 0.f, 0.f};
    bf16x8 At[4][2], B0[2][2], B1[2][2];
    const char* cA = (const char*)g.A + (size_t)cur.pm * tstep; const char* cB = (const char*)g.Bt + (size_t)cur.pn * tstep;
    S.a_ready(cur);
    PG8_STAGE(PG8_SB(0, 0), cB, voffB); PG8_STAGE(PG8_SA(0, 0), cA, voffA); PG8_STAGE(PG8_SB(0, 1), cB + hstep, voffB); PG8_STAGE(PG8_SA(0, 1), cA + hstep, voffA);
    if (wr == 1) PG8_BAR;
    PG8_WAIT_V(4); PG8_BAR;
    PG8_STAGE(PG8_SB(1, 0), cB + kstep, voffB); PG8_STAGE(PG8_SA(1, 0), cA + kstep, voffA); PG8_STAGE(PG8_SB(1, 1), cB + hstep + kstep, voffB);
    PG8_WAIT_V(6); PG8_BAR;
    PG8_STAMP();
    for (;;) {
        const bool has_next = S.next(ui + 1, nxt);
        const char* nA = has_next ? (const char*)g.A + (size_t)nxt.pm * tstep : cA; const char* nB = has_next ? (const char*)g.Bt + (size_t)nxt.pn * tstep : cB;
        for (int t = 0; t < nt; t += 2) {
            const bool last = (t == nt - 2);
            const char* a1 = cA + (size_t)(t + 1) * kstep;
            const char* a2 = last ? nA : cA + (size_t)(t + 2) * kstep; const char* b2 = last ? nB : cB + (size_t)(t + 2) * kstep;
            const char* a3 = a2 + kstep; const char* b3 = b2 + kstep;
            if (last && has_next) S.a_ready(nxt);
            PG8_LDB(B0, 0, 0); PG8_SCHED; PG8_LDA(At, 0, 0); PG8_STAGE(PG8_SA(1, 1), a1 + hstep, voffA);
            PG8_WAIT_L(8); PG8_BAR; PG8_WAIT_L(0); PG8_MMA(0, 0, At, B0); PG8_BAR; PG8_SCHED;
            PG8_LDB(B1, 0, 1); PG8_STAGE(PG8_SB(0, 0), b2, voffB);
            PG8_BAR; PG8_WAIT_L(0); PG8_MMA(0, 1, At, B1); PG8_BAR;
            PG8_LDA(At, 0, 1); PG8_STAGE(PG8_SA(0, 0), a2, voffA);
            PG8_BAR; PG8_WAIT_L(0); PG8_MMA(1, 0, At, B0); PG8_BAR; PG8_SCHED;
            PG8_STAGE(PG8_SB(0, 1), b2 + hstep, voffB);
            PG8_WAIT_V(6); PG8_BAR; PG8_MMA(1, 1, At, B1); PG8_BAR;
            PG8_LDB(B0, 1, 0); PG8_SCHED; PG8_LDA(At, 1, 0); PG8_STAGE(PG8_SA(0, 1), a2 + hstep, voffA);
            PG8_WAIT_L(8); PG8_BAR; PG8_WAIT_L(0); PG8_MMA(0, 0, At, B0); PG8_BAR; PG8_SCHED;
            PG8_LDB(B1, 1, 1); PG8_STAGE(PG8_SB(1, 0), b3, voffB);
            PG8_BAR; PG8_WAIT_L(0); PG8_MMA(0, 1, At, B1); PG8_BAR;
            PG8_LDA(At, 1, 1); PG8_STAGE(PG8_SA(1, 0), a3, voffA);
            PG8_BAR; PG8_WAIT_L(0); PG8_MMA(1, 0, At, B0); PG8_BAR; PG8_SCHED;
            PG8_STAGE(PG8_SB(1, 1), b3 + hstep, voffB);
            PG8_WAIT_V(6); PG8_BAR; PG8_MMA(1, 1, At, B1); PG8_BAR;
        }
        PG8_STAMP();
        if constexpr (!Epi::AFTER_DRAIN) { E(acc, cur, wr, wc, fr, fq); S.done(cur); }
        PG8_STAMP();
        if (!has_next) break;
#pragma unroll
        for (int a = 0; a < 2; ++a)
#pragma unroll
            for (int b = 0; b < 2; ++b)
#pragma unroll
                for (int m = 0; m < 4; ++m)
#pragma unroll
                    for (int n = 0; n < 2; ++n) acc[a][b][m][n] = (f32x4){0.f, 0.f, 0.f, 0.f};
        cur = nxt; cA = nA; cB = nB; ++ui;
    }
    PG8_WAIT_V(0);
    if (wr == 0) PG8_BAR;
    PG8_BAR;
    if constexpr (Epi::AFTER_DRAIN) { E.fused(acc, cur, wr, wc, fr, fq, lds, wid, lane); S.done(cur); }
    PG8_STAMP();
    if (STAMP && wid == 0) { stamps[lane] = lane < nts ? (((unsigned long long)(unsigned)ts_hi << 32) | (unsigned)ts_lo) : 0ull;
        if (lane == 62) stamps[62] = rt_entry; if (lane == 63) stamps[63] = (unsigned long long)wall_clock64(); }
#undef PG8_STAMP
#undef PG8_SA
#undef PG8_SB
#undef PG8_STAGE
#undef PG8_LDA
#undef PG8_LDB
#undef PG8_MMA
#undef PG8_WAIT_V
#undef PG8_WAIT_L
#undef PG8_BAR
#undef PG8_SCHED
}
}

constexpr int T = 16384, D = 2048, SEQ = 4096, NB = 4;
constexpr int NIN = 15360, WIN_LD = 15376;
constexpr float EPS = 1e-6f;
constexpr int NWAVES = 8, NTHR = 512;
constexpr int NPHASE = 11;
constexpr size_t MiB = 1u << 20;
constexpr size_t WS_CTL = 0, CTL_ZERO_BYTES = 64 * 1024;
constexpr size_t WS_GATES = 1 * MiB;
constexpr size_t WS_U = 2 * MiB, WS_MX = WS_U + 512 * 1024, WS_WI = WS_MX + 512 * 1024, WS_WK = WS_WI + 512 * 1024, WS_MR = WS_WK + 512 * 1024, WS_DEN = WS_MR + 512 * 1024, WS_DEC = WS_DEN + 512 * 1024;
constexpr size_t WS_XN = 8 * MiB;
constexpr size_t WS_WIN = 72 * MiB;
constexpr size_t WS_SS = 72 * MiB;
constexpr size_t WS_EXP = 72 * MiB, WS_GATE = 80 * MiB;
constexpr size_t WS_WA = 88 * MiB, WS_WM = 96 * MiB, WS_WO = 104 * MiB, WS_WQ = 112 * MiB;
constexpr size_t WS_KEYS = 120 * MiB;
constexpr size_t WS_Q = 132 * MiB;
constexpr size_t WS_K = 196 * MiB;
constexpr size_t WS_AQ = 260 * MiB;
constexpr size_t WS_TMP = 196 * MiB;
constexpr size_t WS_KT = 324 * MiB;
constexpr size_t WS_VT = 388 * MiB;
constexpr size_t WS_SO = 452 * MiB;
constexpr size_t WS_AK = 516 * MiB, WS_AV = 532 * MiB;
constexpr size_t WS_END = 548 * MiB;
constexpr int CW_BAR = 4096;

constexpr int LDS_BYTES = 147456;
constexpr int MISC_OFF = 131072 + 8192;

#define GAS __attribute__((address_space(1)))
#define LAS __attribute__((address_space(3)))
typedef unsigned short bf16_t;
typedef float f32x4 __attribute__((ext_vector_type(4)));
typedef float f32x16 __attribute__((ext_vector_type(16)));
typedef short bf16x8 __attribute__((ext_vector_type(8)));
typedef short s16x4 __attribute__((ext_vector_type(4)));
typedef unsigned u32x4 __attribute__((ext_vector_type(4)));
typedef unsigned u32x2 __attribute__((ext_vector_type(2)));
typedef __bf16 bf2_t __attribute__((ext_vector_type(2)));

__device__ __forceinline__ unsigned f2bf(float f) { return (unsigned)__builtin_bit_cast(unsigned short, (__bf16)f); }
__device__ __forceinline__ unsigned cvtpk(float lo, float hi) { bf2_t v; v[0] = (__bf16)lo; v[1] = (__bf16)hi; return __builtin_bit_cast(unsigned, v); }
__device__ __forceinline__ unsigned pk2(float lo, float hi) { return cvtpk(lo, hi); }
__device__ __forceinline__ float bflo(unsigned u) { return __uint_as_float(u << 16); }
__device__ __forceinline__ float bfhi(unsigned u) { return __uint_as_float(u & 0xffff0000u); }
__device__ __forceinline__ float wave_sum(float v) {
#pragma unroll
    for (int o = 1; o < 64; o <<= 1) v += __shfl_xor(v, o);
    return v;
}
__device__ __forceinline__ float sigmoidf_(float x) { return __builtin_amdgcn_rcpf(1.0f + __expf(-x)); }
__device__ __forceinline__ bf16x8 pack8(const f32x4 a, const f32x4 b) {
    u32x4 w; w.x = cvtpk(a[0], a[1]); w.y = cvtpk(a[2], a[3]); w.z = cvtpk(b[0], b[1]); w.w = cvtpk(b[2], b[3]);
    return __builtin_bit_cast(bf16x8, w);
}
#define MFMA16(a, b, c) __builtin_amdgcn_mfma_f32_16x16x32_bf16((a), (b), (c), 0, 0, 0)
#define GLDS16(gptr, ldsptr) __builtin_amdgcn_global_load_lds((const unsigned*)(gptr), (LAS unsigned*)(ldsptr), 16, 0, 0)
#define GLDS4(gptr, ldsptr) __builtin_amdgcn_global_load_lds((const unsigned*)(gptr), (LAS unsigned*)(ldsptr), 4, 0, 0)
#define VM_WAIT() asm volatile("s_waitcnt vmcnt(0)" ::: "memory")

#define XB_TMO      128
#define XB_XCNT(j)  (256  + 64 * (j))
#define XB_XSUB(j)  (1280 + 64 * (j))
#define XB_XGEN(j)  (2304 + 64 * (j))
#define XB_TOP      3328
#define XB_TOPGEN   3392
#define XCD_BAR_WORDS 3456
#define XB_SPIN_CAP (1u << 18)

__device__ __forceinline__ unsigned xb_ld(unsigned* p)              { return __hip_atomic_load(p, __ATOMIC_RELAXED, __HIP_MEMORY_SCOPE_AGENT); }
__device__ __forceinline__ unsigned xb_add(unsigned* p, unsigned v) { return __hip_atomic_fetch_add(p, v, __ATOMIC_RELAXED, __HIP_MEMORY_SCOPE_AGENT); }
__device__ __forceinline__ unsigned xb_xcc_id() { return (unsigned)__builtin_amdgcn_s_getreg((3 << 11) | 20) & 0xFu; }
#define XB_SPIN(cond, bar) do { unsigned _sp = 0; while (cond) { __builtin_amdgcn_s_sleep(1); \
    if ((++_sp & 255u) == 0u) { if (xb_ld(&(bar)[XB_TMO])) break; if (_sp > XB_SPIN_CAP) { atomicAdd(&(bar)[XB_TMO], 1u); break; } } } } while (0)

struct XcdBarrier {
    unsigned* bar; unsigned x;
    volatile LAS unsigned* st;
};

__device__ __forceinline__ XcdBarrier xcd_barrier_post(unsigned* bar, volatile LAS unsigned* st) {
    XcdBarrier b; b.bar = bar; b.x = xb_xcc_id(); b.st = st;
    if (threadIdx.x == 0) (void)xb_add(&bar[XB_XCNT(b.x)], 1u);
    return b;
}
__device__ __forceinline__ void xcd_barrier_complete(unsigned* bar, unsigned x, unsigned& nloc, unsigned& nx) {
    const unsigned G = gridDim.x * gridDim.y * gridDim.z;
    unsigned sum, cnt, mine, sp = 0u;
    for (;;) {
        sum = 0u; cnt = 0u; mine = 0u;
#pragma unroll
        for (unsigned j = 0; j < 16; ++j) { const unsigned c = xb_ld(&bar[XB_XCNT(j)]); sum += c; cnt += (c > 0u) ? 1u : 0u; mine = (j == x) ? c : mine; }
        if (sum == G) break;
        __builtin_amdgcn_s_sleep(1);
        if ((++sp & 255u) == 0u) { if (xb_ld(&bar[XB_TMO])) break; if (sp > XB_SPIN_CAP) { atomicAdd(&bar[XB_TMO], 1u); break; } }
    }
    nloc = mine > 0u ? mine : 1u; nx = cnt > 0u ? cnt : 1u;
}

__device__ __forceinline__ void xcd_barrier(const XcdBarrier& b) {
    asm volatile("s_waitcnt vmcnt(0)" ::: "memory");
    __syncthreads();
    if (threadIdx.x == 0) {
        unsigned* bar = b.bar;
        __builtin_amdgcn_s_waitcnt(0);
        unsigned nloc = b.st[0], nx = b.st[1];
        if (nloc == 0u) { xcd_barrier_complete(bar, b.x, nloc, nx); b.st[0] = nloc; b.st[1] = nx; }
        const unsigned old = xb_add(&bar[XB_XSUB(b.x)], 1u);
        const unsigned gen = old / nloc;
        if (old + 1u == (gen + 1u) * nloc) {
            __builtin_amdgcn_fence(__ATOMIC_RELEASE, "agent");
            asm volatile("s_waitcnt vmcnt(0)" ::: "memory");
            const unsigned og = xb_add(&bar[XB_TOP], 1u);
            const unsigned tg = og / nx;
            if (og + 1u == (tg + 1u) * nx) xb_add(&bar[XB_TOPGEN], 1u);
            else XB_SPIN(xb_ld(&bar[XB_TOPGEN]) == tg, bar);
            __builtin_amdgcn_fence(__ATOMIC_ACQUIRE, "agent");
            xb_add(&bar[XB_XGEN(b.x)], 1u);
            asm volatile("s_waitcnt vmcnt(0)" ::: "memory");
        } else {
            XB_SPIN(xb_ld(&bar[XB_XGEN(b.x)]) == gen, bar);
            __builtin_amdgcn_fence(__ATOMIC_ACQUIRE, "agent");
            asm volatile("s_waitcnt vmcnt(0)" ::: "memory");
        }
    }
    __syncthreads();
}

struct EpiInProj {
    static constexpr bool PERM = true, AFTER_DRAIN = false;
    bf16_t *Q, *K, *KT, *VT, *SO, *AQ, *AK, *AV, *GM, *GA;
    template <int ACT>
    __device__ __forceinline__ void rows(const f32x4 (&acc)[2][2][4][2], bf16_t* dst, int ldc, int colt, float scale, int row0, int wc, int fq) const {
#pragma unroll
        for (int ai = 0; ai < 2; ++ai)
#pragma unroll
            for (int m = 0; m < 4; ++m) { bf16_t* rowp = dst + (size_t)(row0 + ai * 128 + m * 16) * ldc + colt + wc * 32 + 8 * fq;
#pragma unroll
                for (int bj = 0; bj < 2; ++bj) { f32x4 v0 = acc[ai][bj][m][0], v1 = acc[ai][bj][m][1];
                    if (ACT == 1) {
#pragma unroll
                        for (int j = 0; j < 4; ++j) { v0[j] = sigmoidf_(v0[j]); v1[j] = sigmoidf_(v1[j]); } }
                    else { v0 = v0 * scale; v1 = v1 * scale; }
                    u32x4 w; w.x = cvtpk(v0[0], v0[1]); w.y = cvtpk(v0[2], v0[3]); w.z = cvtpk(v1[0], v1[1]); w.w = cvtpk(v1[2], v1[3]);
                    *(u32x4*)(rowp + bj * 128) = w; } }
    }
    __device__ __forceinline__ void rowsT(const f32x4 (&acc)[2][2][4][2], bf16_t* dst, int colt, float scale, int row0, int wc, int fq) const {
        const int head = colt >> 9, d0 = (colt & 511) + wc * 32 + 8 * fq;
#pragma unroll
        for (int ai = 0; ai < 2; ++ai)
#pragma unroll
            for (int m = 0; m < 4; ++m) { const int r = row0 + ai * 128 + m * 16, b = r >> 12, s = r & 4095, chunk = s >> 6, j = s & 63;
                bf16_t* base = dst + ((size_t)((b * 4 + head) * 64 + chunk) * 512) * 64 + j;
#pragma unroll
                for (int bj = 0; bj < 2; ++bj)
#pragma unroll
                    for (int n = 0; n < 2; ++n)
#pragma unroll
                        for (int e = 0; e < 4; ++e) base[(size_t)(d0 + bj * 128 + 4 * n + e) * 64] = (bf16_t)f2bf(acc[ai][bj][m][n][e] * scale); }
    }
    __device__ __forceinline__ void operator()(const f32x4 (&acc)[2][2][4][2], const pg8::Unit& u, int wr, int wc, int fr, int fq) const {
        const int pn = u.pn, row0 = u.pm * 256 + wr * 64 + fr;
        if (pn < 8) rows<0>(acc, Q, D, pn * 256, 1.0f, row0, wc, fq);
        else if (pn < 16) { rows<0>(acc, K, D, (pn - 8) * 256, 0.04419417382415922f, row0, wc, fq); rowsT(acc, KT, (pn - 8) * 256, 0.04419417382415922f, row0, wc, fq); }
        else if (pn < 24) rowsT(acc, VT, (pn - 16) * 256, 1.0f, row0, wc, fq);
        else if (pn < 32) rows<1>(acc, SO, D, (pn - 24) * 256, 1.0f, row0, wc, fq);
        else if (pn < 40) rows<0>(acc, AQ, D, (pn - 32) * 256, 1.0f, row0, wc, fq);
        else if (pn < 42) rows<0>(acc, AK, 512, (pn - 40) * 256, 1.0f, row0, wc, fq);
        else if (pn < 44) rows<0>(acc, AV, 512, (pn - 42) * 256, 1.0f, row0, wc, fq);
        else if (pn < 52) rows<1>(acc, GM, D, (pn - 44) * 256, 1.0f, row0, wc, fq);
        else rows<1>(acc, GA, D, (pn - 52) * 256, 1.0f, row0, wc, fq);
    }
};
struct EpiGateF32 {
    static constexpr bool PERM = true, AFTER_DRAIN = false;
    const bf16_t* G; float* TMP;
    __device__ __forceinline__ void operator()(const f32x4 (&acc)[2][2][4][2], const pg8::Unit& u, int wr, int wc, int fr, int fq) const {
        const int row0 = u.pm * 256 + wr * 64 + fr, col0 = u.pn * 256 + wc * 32 + 8 * fq;
#pragma unroll
        for (int ai = 0; ai < 2; ++ai)
#pragma unroll
            for (int m = 0; m < 4; ++m) { const size_t off = (size_t)(row0 + ai * 128 + m * 16) * D + col0;
#pragma unroll
                for (int bj = 0; bj < 2; ++bj) { const u32x4 g = *(const u32x4*)(G + off + bj * 128);
                    f32x4 o0, o1; o0[0] = bflo(g.x); o0[1] = bfhi(g.x); o0[2] = bflo(g.y); o0[3] = bfhi(g.y); o1[0] = bflo(g.z); o1[1] = bfhi(g.z); o1[2] = bflo(g.w); o1[3] = bfhi(g.w);
                    *(f32x4*)(TMP + off + bj * 128) = o0 * acc[ai][bj][m][0]; *(f32x4*)(TMP + off + bj * 128 + 4) = o1 * acc[ai][bj][m][1]; } }
    }
};
struct EpiMerge {
    static constexpr bool PERM = true, AFTER_DRAIN = false;
    const bf16_t* G; const float* TMP; bf16_t* OUT;
    __device__ __forceinline__ void operator()(const f32x4 (&acc)[2][2][4][2], const pg8::Unit& u, int wr, int wc, int fr, int fq) const {
        const int row0 = u.pm * 256 + wr * 64 + fr, col0 = u.pn * 256 + wc * 32 + 8 * fq;
#pragma unroll
        for (int ai = 0; ai < 2; ++ai)
#pragma unroll
            for (int m = 0; m < 4; ++m) { const size_t off = (size_t)(row0 + ai * 128 + m * 16) * D + col0;
#pragma unroll
                for (int bj = 0; bj < 2; ++bj) { const u32x4 g = *(const u32x4*)(G + off + bj * 128);
                    const f32x4 t0 = *(const f32x4*)(TMP + off + bj * 128), t1 = *(const f32x4*)(TMP + off + bj * 128 + 4);
                    f32x4 o0, o1; o0[0] = bflo(g.x); o0[1] = bfhi(g.x); o0[2] = bflo(g.y); o0[3] = bfhi(g.y); o1[0] = bflo(g.z); o1[1] = bfhi(g.z); o1[2] = bflo(g.w); o1[3] = bfhi(g.w);
                    o0 = o0 * acc[ai][bj][m][0] + t0; o1 = o1 * acc[ai][bj][m][1] + t1;
                    u32x4 w; w.x = cvtpk(o0[0], o0[1]); w.y = cvtpk(o0[2], o0[3]); w.z = cvtpk(o1[0], o1[1]); w.w = cvtpk(o1[2], o1[3]);
                    *(u32x4*)(OUT + off + bj * 128) = w; } }
    }
};
struct EpiResid {
    static constexpr bool PERM = false, AFTER_DRAIN = false;
    const float* BASE; float* OUT;
    __device__ __forceinline__ void operator()(const f32x4 (&acc)[2][2][4][2], const pg8::Unit& u, int wr, int wc, int fr, int fq) const {
        const int row0 = u.pm * 256 + wr * 64 + fr, col0 = u.pn * 256 + wc * 32 + 4 * fq;
#pragma unroll
        for (int ai = 0; ai < 2; ++ai)
#pragma unroll
            for (int m = 0; m < 4; ++m) { const size_t off = (size_t)(row0 + ai * 128 + m * 16) * D + col0;
#pragma unroll
                for (int bj = 0; bj < 2; ++bj)
#pragma unroll
                    for (int n = 0; n < 2; ++n) *(f32x4*)(OUT + off + bj * 128 + n * 16) = *(const f32x4*)(BASE + off + bj * 128 + n * 16) + acc[ai][bj][m][n]; }
    }
};
struct EpiPlainBf16 {
    static constexpr bool PERM = true, AFTER_DRAIN = false;
    bf16_t* OUT;
    __device__ __forceinline__ void operator()(const f32x4 (&acc)[2][2][4][2], const pg8::Unit& u, int wr, int wc, int fr, int fq) const {
        const int row0 = u.pm * 256 + wr * 64 + fr, col0 = u.pn * 256 + wc * 32 + 8 * fq;
#pragma unroll
        for (int ai = 0; ai < 2; ++ai)
#pragma unroll
            for (int m = 0; m < 4; ++m) { const size_t off = (size_t)(row0 + ai * 128 + m * 16) * D + col0;
#pragma unroll
                for (int bj = 0; bj < 2; ++bj) { const f32x4 v0 = acc[ai][bj][m][0], v1 = acc[ai][bj][m][1];
                    u32x4 w; w.x = cvtpk(v0[0], v0[1]); w.y = cvtpk(v0[2], v0[3]); w.z = cvtpk(v1[0], v1[1]); w.w = cvtpk(v1[2], v1[3]);
                    *(u32x4*)(OUT + off + bj * 128) = w; } }
    }
};

struct Args {
    const float *x, *norm1_g, *w_in, *gate_b, *mnorm_g, *w_m, *gq, *gk, *sink, *rel_bias, *w_a, *w_out, *norm2_g, *peer_wq, *peer_keys, *peer_u, *peer_v;
    float* out; unsigned char* ws; int ph_lo, ph_hi;
};

__device__ __forceinline__ void transpose_item(const float* W, int ldw, int K, int nblk, bf16_t* WT, LAS float* scr, int item, int lane, bool skip16) {
    const int kb = item / nblk, nb = item % nblk, k0 = 64 * kb, n0 = 32 * nb, ns = n0 + ((skip16 && n0 >= 8192) ? 16 : 0);
#pragma unroll 8
    for (int i = 0; i < 32; ++i) { const int kk = 2 * i + (lane >> 5); scr[kk * 33 + (lane & 31)] = W[(size_t)(k0 + kk) * ldw + ns + (lane & 31)]; }
    asm volatile("s_waitcnt lgkmcnt(0)" ::: "memory");
    const int c = lane & 7;
#pragma unroll
    for (int j = 0; j < 4; ++j) { const int n = (lane >> 3) + 8 * j; const LAS float* s = scr + (8 * c) * 33 + n;
        u32x4 o; o.x = pk2(s[0 * 33], s[1 * 33]); o.y = pk2(s[2 * 33], s[3 * 33]); o.z = pk2(s[4 * 33], s[5 * 33]); o.w = pk2(s[6 * 33], s[7 * 33]);
        *(u32x4*)(WT + (size_t)(n0 + n) * K + k0 + 8 * c) = o; }
    asm volatile("s_waitcnt lgkmcnt(0)" ::: "memory");
}
__device__ __forceinline__ void convert_stream(const float* src, bf16_t* dst, size_t n, int gthread, int nthreads) {
    for (size_t i = (size_t)gthread * 8; i < n; i += (size_t)nthreads * 8) {
        const f32x4 a = *(const f32x4*)(src + i), b = *(const f32x4*)(src + i + 4);
        u32x4 w; w.x = pk2(a[0], a[1]); w.y = pk2(a[2], a[3]); w.z = pk2(b[0], b[1]); w.w = pk2(b[2], b[3]);
        *(u32x4*)(dst + i) = w; }
}

__device__ __forceinline__ void p0_prologue(const Args& A, LAS unsigned char* lds, int tid, int lane, int wave, int G) {
    unsigned char* ws = A.ws;
    bf16_t* XN = (bf16_t*)(ws + WS_XN); float* GATES = (float*)(ws + WS_GATES); bf16_t* WIN = (bf16_t*)(ws + WS_WIN);
    LAS float* wg = (LAS float*)lds;
    for (int idx = tid; idx < 32768; idx += NTHR) { const int k = idx >> 4, g = idx & 15; wg[g * 2048 + k] = A.w_in[(size_t)k * WIN_LD + 8192 + g]; }
    __syncthreads();
    const int gw = blockIdx.x * NWAVES + wave, NGW = G * NWAVES;
    for (int row = gw; row < T; row += NGW) {
        float ss = 0.f;
#pragma unroll
        for (int j = 0; j < 8; ++j) { const f32x4 v = *(const f32x4*)(A.x + (size_t)row * D + 4 * lane + 256 * j); ss += (v[0] * v[0] + v[1] * v[1]) + (v[2] * v[2] + v[3] * v[3]); }
        const float rstd = 1.0f / sqrtf(wave_sum(ss) * (1.0f / D) + EPS);
        float acc[16];
#pragma unroll
        for (int g = 0; g < 16; ++g) acc[g] = 0.f;
#pragma unroll 1
        for (int j = 0; j < 8; ++j) { f32x4 v = *(const f32x4*)(A.x + (size_t)row * D + 4 * lane + 256 * j); const f32x4 gv = *(const f32x4*)(A.norm1_g + 4 * lane + 256 * j);
            v = v * rstd * gv;
            u32x2 w; w.x = pk2(v[0], v[1]); w.y = pk2(v[2], v[3]);
            *(u32x2*)(XN + (size_t)row * D + 4 * lane + 256 * j) = w;
            const LAS float* wgj = wg + 4 * lane + 256 * j;
#pragma unroll
            for (int g = 0; g < 16; ++g) { const f32x4 w4 = *(const LAS f32x4*)(wgj + g * 2048); acc[g] += (v[0] * w4[0] + v[1] * w4[1]) + (v[2] * w4[2] + v[3] * w4[3]); } }
#pragma unroll
        for (int i = 0; i < 8; ++i) { const float send = (lane & 1) ? acc[i] : acc[i + 8], keep = (lane & 1) ? acc[i + 8] : acc[i]; acc[i] = keep + __shfl_xor(send, 1); }
#pragma unroll
        for (int i = 0; i < 4; ++i) { const float send = (lane & 2) ? acc[i] : acc[i + 4], keep = (lane & 2) ? acc[i + 4] : acc[i]; acc[i] = keep + __shfl_xor(send, 2); }
#pragma unroll
        for (int i = 0; i < 2; ++i) { const float send = (lane & 4) ? acc[i] : acc[i + 2], keep = (lane & 4) ? acc[i + 2] : acc[i]; acc[i] = keep + __shfl_xor(send, 4); }
        { const float send = (lane & 8) ? acc[0] : acc[1], keep = (lane & 8) ? acc[1] : acc[0]; acc[0] = keep + __shfl_xor(send, 8); }
        float tot = acc[0]; tot += __shfl_xor(tot, 16); tot += __shfl_xor(tot, 32);
        const int gidx = ((lane & 1) << 3) | ((lane & 2) << 1) | ((lane & 4) >> 1) | ((lane & 8) >> 3);
        if (lane < 16) GATES[(size_t)row * 16 + gidx] = tot;
    }
    __syncthreads();
    LAS float* scr = (LAS float*)(lds + wave * 8704);
    constexpr int NBLK = NIN / 32, NITEMS = (D / 64) * NBLK;
    for (int it = gw; it < NITEMS; it += NGW) transpose_item(A.w_in, WIN_LD, D, NBLK, WIN, scr, it, lane, true);
}

__device__ __forceinline__ float logsigmoidf_(float x) { return fminf(x, 0.f) - log1pf(__expf(-fabsf(x))); }
__device__ __forceinline__ void gate_scan(const Args& A, LAS unsigned char* lds, int chain, int tid, int lane, int wave) {
    unsigned char* ws = A.ws;
    const float* GATES = (const float*)(ws + WS_GATES);
    float *U = (float*)(ws + WS_U), *MX = (float*)(ws + WS_MX), *WI = (float*)(ws + WS_WI), *WK = (float*)(ws + WS_WK), *MR = (float*)(ws + WS_MR), *DEC = (float*)(ws + WS_DEC);
    LAS float* BL = (LAS float*)lds; LAS float* PA = BL + 64; LAS float* MC = BL + 128; LAS float* MN = BL + 192;
    const int dir = chain & 1, bh = chain >> 1, b = bh >> 2, h = bh & 3;
    const float bi = A.gate_b[(dir * 2 + 0) * 4 + h], bf = A.gate_b[(dir * 2 + 1) * 4 + h];
    float bc[8], uu[8], pm[8];
#pragma unroll
    for (int i = 0; i < 8; ++i) { const int c = wave * 8 + i; const size_t t = (size_t)b * SEQ + 64 * c + lane;
        const float gi = GATES[t * 16 + dir * 8 + h] + bi, gf = GATES[t * 16 + dir * 8 + 4 + h] + bf;
        float s = logsigmoidf_(gf);
        if (!dir) {
#pragma unroll
            for (int o = 1; o < 64; o <<= 1) { const float t2 = __shfl_up(s, o); if (lane >= o) s += t2; }
        } else {
#pragma unroll
            for (int o = 1; o < 64; o <<= 1) { const float t2 = __shfl_down(s, o); if (lane + o < 64) s += t2; }
        }
        float u = gi - s, p = u;
        if (!dir) {
#pragma unroll
            for (int o = 1; o < 64; o <<= 1) { const float t2 = __shfl_up(p, o); if (lane >= o) p = fmaxf(p, t2); }
        } else {
#pragma unroll
            for (int o = 1; o < 64; o <<= 1) { const float t2 = __shfl_down(p, o); if (lane + o < 64) p = fmaxf(p, t2); }
        }
        bc[i] = s; uu[i] = u; pm[i] = p;
        const float blast = __shfl(s, dir ? 0 : 63), pall = __shfl(p, dir ? 0 : 63);
        if (lane == 0) { BL[c] = blast; PA[c] = pall; }
    }
    __syncthreads();
    if (tid == 0) { float m = 0.f; for (int ci = 0; ci < 64; ++ci) { const int c = dir ? 63 - ci : ci; MC[c] = m; m = BL[c] + fmaxf(m, PA[c]); MN[c] = m; } }
    __syncthreads();
#pragma unroll
    for (int i = 0; i < 8; ++i) { const int c = wave * 8 + i; const size_t o = (size_t)chain * SEQ + 64 * c + lane;
        const float m = MC[c], mn = MN[c], bl = BL[c], mx = fmaxf(m, pm[i]);
        U[o] = uu[i]; MX[o] = mx; WI[o] = __expf(m - mx); MR[o] = bc[i] + mx; WK[o] = __expf(bl + uu[i] - mn);
        if (lane == 0) DEC[chain * 64 + c] = __expf(bl + m - mn); }
    __syncthreads();
}

__device__ __forceinline__ unsigned offb(unsigned row, unsigned ch) { return 256u * row + 16u * (ch ^ (((row & 3u) << 2) | ((row >> 2) & 3u))); }
__device__ __forceinline__ int t5_bucket_abs(int n) { return n < 8 ? n : n < 12 ? 8 : n < 16 ? 9 : n < 23 ? 10 : n < 32 ? 11 : n < 46 ? 12 : n < 64 ? 13 : n < 91 ? 14 : 15; }
constexpr int AT_RSTD = 98304, AT_BIAS = AT_RSTD + 1536, AT_GQK = AT_BIAS + 1040;

__device__ __forceinline__ void attn_band_load(const bf16_t* SRC, LAS unsigned char* lds, int b, int qb, int kvh, int wave, int lane) {
#pragma unroll
    for (int ii = 0; ii < 12; ++ii) { const int i = wave * 12 + ii, row = 4 * i + (lane >> 4), cpos = lane & 15;
        const int ch = cpos ^ (((row & 3) << 2) | ((row >> 2) & 3));
        int kp = 128 * (qb - 1) + row; kp = kp < 0 ? 0 : (kp > SEQ - 1 ? SEQ - 1 : kp);
        const bf16_t* src = SRC + (size_t)(b * SEQ + kp) * 512 + kvh * 128 + 8 * ch;
        GLDS16(src, lds + i * 1024); }
}

__device__ __forceinline__ void attn_unit(const Args& A, LAS unsigned char* lds, int unit, int tid, int lane, int wave) {
    unsigned char* ws = A.ws;
    const bf16_t *AQ = (const bf16_t*)(ws + WS_AQ), *AK = (const bf16_t*)(ws + WS_AK), *AV = (const bf16_t*)(ws + WS_AV); bf16_t* HA = (bf16_t*)(ws + WS_XN);
    const int head = unit & 15, qb = (unit >> 4) & 31, b = unit >> 9, kvh = head >> 2;
    const int g = lane >> 4, ql = lane & 15;
    LAS float* RSTD = (LAS float*)(lds + AT_RSTD); LAS float* BIAS = (LAS float*)(lds + AT_BIAS); LAS float* GQK = (LAS float*)(lds + AT_GQK);
    attn_band_load(AK, lds, b, qb, kvh, wave, lane);
    if (tid < 257) { const int rel = tid - 128; const int bk = t5_bucket_abs(rel < 0 ? -rel : rel) + (rel > 0 ? 16 : 0); BIAS[tid] = A.rel_bias[bk * 16 + head]; }
    if (tid >= 384) { const int d = tid - 384; GQK[d] = A.gq[d] * A.gk[d] * 0.08838834764831845f; }
    const size_t trow = (size_t)b * SEQ + 128 * qb + 16 * wave + ql;
    u32x4 qraw[4]; float ss = 0.f;
#pragma unroll
    for (int s = 0; s < 4; ++s) { qraw[s] = *(const u32x4*)(AQ + trow * D + head * 128 + 32 * s + 8 * g);
#pragma unroll
        for (int j = 0; j < 4; ++j) { const float lo = bflo(qraw[s][j]), hi = bfhi(qraw[s][j]); ss += lo * lo + hi * hi; } }
    ss += __shfl_xor(ss, 16); ss += __shfl_xor(ss, 32);
    const float rstdq = 1.0f / sqrtf(ss * (1.0f / 128.0f) + EPS);
    VM_WAIT(); __syncthreads();
#pragma unroll
    for (int pss = 0; pss < 3; ++pss) { const int row = 48 * wave + 16 * pss + (lane >> 2), qtr = lane & 3; float s2 = 0.f;
#pragma unroll
        for (int i = 0; i < 4; ++i) { const u32x4 kk = *(const LAS u32x4*)(lds + offb(row, 4 * qtr + i));
#pragma unroll
            for (int j = 0; j < 4; ++j) { const float lo = bflo(kk[j]), hi = bfhi(kk[j]); s2 += lo * lo + hi * hi; } }
        s2 += __shfl_xor(s2, 1); s2 += __shfl_xor(s2, 2);
        if (qtr == 0) RSTD[row] = 1.0f / sqrtf(s2 * (1.0f / 128.0f) + EPS); }
    bf16x8 qf[4];
#pragma unroll
    for (int s = 0; s < 4; ++s) { const f32x4 g0 = *(const LAS f32x4*)(GQK + 32 * s + 8 * g), g1 = *(const LAS f32x4*)(GQK + 32 * s + 8 * g + 4);
        u32x4 w;
        w.x = cvtpk(bflo(qraw[s].x) * rstdq * g0[0], bfhi(qraw[s].x) * rstdq * g0[1]); w.y = cvtpk(bflo(qraw[s].y) * rstdq * g0[2], bfhi(qraw[s].y) * rstdq * g0[3]);
        w.z = cvtpk(bflo(qraw[s].z) * rstdq * g1[0], bfhi(qraw[s].z) * rstdq * g1[1]); w.w = cvtpk(bflo(qraw[s].w) * rstdq * g1[2], bfhi(qraw[s].w) * rstdq * g1[3]);
        qf[s] = __builtin_bit_cast(bf16x8, w); }
    __syncthreads();
    const int T0 = wave >> 1;
    f32x4 sc[18];
    {
        const unsigned rlo = 8 * (ql >> 2) + (ql & 3);
        unsigned kb_[2][4];
#pragma unroll
        for (int hf = 0; hf < 2; ++hf)
#pragma unroll
            for (int s = 0; s < 4; ++s) kb_[hf][s] = offb(32 * T0 + rlo + 4 * hf, 4 * s + g);
#pragma unroll
        for (int t = 0; t < 18; ++t) { sc[t] = (f32x4){0.f, 0.f, 0.f, 0.f};
#pragma unroll
            for (int s = 0; s < 4; ++s) { const bf16x8 kf = *(const LAS bf16x8*)(lds + kb_[t & 1][s] + 8192 * (t >> 1)); sc[t] = MFMA16(kf, qf[s], sc[t]); } }
    }
    const float sink = A.sink[head];
    float mx = sink;
    {
        const int kb_l = 32 * T0 + 8 * g;
        const int relb = kb_l - 128 - 16 * wave - ql, kpb = 128 * (qb - 1) + kb_l;
        const LAS float* rs_l = RSTD + kb_l; const LAS float* bs_l = BIAS + (relb + 128);
#pragma unroll
        for (int t = 0; t < 18; ++t) { constexpr int dummy = 0; (void)dummy; const int c0 = 32 * (t >> 1) + 4 * (t & 1); const f32x4 rk = *(const LAS f32x4*)(rs_l + c0);
#pragma unroll
            for (int e = 0; e < 4; ++e) { const int rel = relb + (c0 + e), kp = kpb + (c0 + e);
                const bool ok = (rel >= -128) && (rel <= 128) && (kp >= 0) && (kp < SEQ);
                const float bv = bs_l[c0 + e];
                const float v = ok ? sc[t][e] * rk[e] + bv : -1e30f; sc[t][e] = v; mx = fmaxf(mx, v); } }
    }
    mx = fmaxf(mx, __shfl_xor(mx, 16)); mx = fmaxf(mx, __shfl_xor(mx, 32));
    float l = 0.f;
#pragma unroll
    for (int t = 0; t < 18; ++t)
#pragma unroll
        for (int e = 0; e < 4; ++e) { const float p = __expf(sc[t][e] - mx); sc[t][e] = p; l += p; }
    l += __shfl_xor(l, 16); l += __shfl_xor(l, 32);
    l += __expf(sink - mx);
    const float rl = 1.0f / l;
    __syncthreads();
    attn_band_load(AV, lds, b, qb, kvh, wave, lane);
    bf16x8 pf[9];
#pragma unroll
    for (int tt = 0; tt < 9; ++tt) pf[tt] = pack8(sc[2 * tt] * rl, sc[2 * tt + 1] * rl);
    VM_WAIT(); __syncthreads();
    f32x4 o[8];
    {
        const unsigned q4 = ql >> 2, p = ql & 3, r0 = 32 * T0 + 8 * g + q4;
#pragma unroll
        for (int n = 0; n < 8; ++n) { o[n] = (f32x4){0.f, 0.f, 0.f, 0.f};
            const unsigned b0 = offb(r0, 2 * n + (p >> 1)) + 8 * (p & 1), b1 = offb(r0 + 4, 2 * n + (p >> 1)) + 8 * (p & 1);
#pragma unroll
            for (int tt = 0; tt < 9; ++tt) {
                const s16x4 v0 = __builtin_amdgcn_ds_read_tr16_b64_v4i16((LAS s16x4*)(lds + b0 + 8192 * tt));
                const s16x4 v1 = __builtin_amdgcn_ds_read_tr16_b64_v4i16((LAS s16x4*)(lds + b1 + 8192 * tt));
                bf16x8 vf; vf[0] = v0[0]; vf[1] = v0[1]; vf[2] = v0[2]; vf[3] = v0[3]; vf[4] = v1[0]; vf[5] = v1[1]; vf[6] = v1[2]; vf[7] = v1[3];
                o[n] = MFMA16(vf, pf[tt], o[n]); } }
    }
#pragma unroll
    for (int n = 0; n < 8; ++n) { u32x2 w; w.x = cvtpk(o[n][0], o[n][1]); w.y = cvtpk(o[n][2], o[n][3]);
        *(u32x2*)(HA + trow * D + head * 128 + 16 * n + 4 * g) = w; }
    __syncthreads();
}

__device__ __forceinline__ void ss_unit(const Args& A, int unit, int lane, int wave) {
    unsigned char* ws = A.ws;
    const bf16_t *Q = (const bf16_t*)(ws + WS_Q), *K = (const bf16_t*)(ws + WS_K); bf16_t* SS = (bf16_t*)(ws + WS_SS);
    const float *U = (const float*)(ws + WS_U), *MX = (const float*)(ws + WS_MX);
    const int c = unit & 63, bh = unit >> 6, b = bh >> 2, h = bh & 3, d = wave >> 2, m = wave & 3, ch = bh * 2 + d;
    const int g = lane >> 4, r = lane & 15;
    const size_t t0 = (size_t)b * SEQ + 64 * c;
    f32x4 acc[4];
#pragma unroll
    for (int n = 0; n < 4; ++n) acc[n] = (f32x4){0.f, 0.f, 0.f, 0.f};
#pragma unroll 4
    for (int ks = 0; ks < 16; ++ks) { const bf16x8 qfr = *(const bf16x8*)(Q + (t0 + 16 * m + r) * D + h * 512 + 32 * ks + 8 * g);
#pragma unroll
        for (int n = 0; n < 4; ++n) { const bf16x8 kfr = *(const bf16x8*)(K + (t0 + 16 * n + r) * D + h * 512 + 32 * ks + 8 * g); acc[n] = MFMA16(kfr, qfr, acc[n]); } }
    const int j = 16 * m + r; const float mxj = MX[(size_t)ch * SEQ + 64 * c + j];
#pragma unroll
    for (int n = 0; n < 4; ++n) { const int s0 = 16 * n + 4 * g; const f32x4 us = *(const f32x4*)(U + (size_t)ch * SEQ + 64 * c + s0);
        float v[4];
#pragma unroll
        for (int e = 0; e < 4; ++e) { const int s = s0 + e; const bool ok = d ? (s >= j) : (s <= j); v[e] = ok ? acc[n][e] * __expf(us[e] - mxj) : 0.f; }
        u32x2 w; w.x = cvtpk(v[0], v[1]); w.y = cvtpk(v[2], v[3]);
        *(u32x2*)(SS + ((size_t)(ch * 64 + c) * 64 + j) * 64 + s0) = w; }
}

constexpr int ML_SMALL = 65536, ML_SMALL_STRIDE = 17408;
__device__ __forceinline__ void ml_issue_piece(const bf16_t* Q, const bf16_t* KT, LAS unsigned char* lds, int step, int dir, int b, int h, int bh, int wave, int lane) {
    const int ci = step >> 2, p = step & 3, c = dir ? 63 - ci : ci, slot = step & 1;
    LAS unsigned char* qp = lds + slot * 32768; LAS unsigned char* kp = qp + 16384;
#pragma unroll
    for (int ii = 0; ii < 2; ++ii) { const int i = 2 * wave + ii;
        { const int row = 4 * i + (lane >> 4), cpos = lane & 15, sch = cpos ^ (row & 15);
          GLDS16(Q + ((size_t)b * SEQ + 64 * c + row) * D + h * 512 + 128 * p + 8 * sch, qp + i * 1024); }
        { const int line = 4 * i + (lane >> 4), cpos = lane & 15, c16 = cpos ^ (line & 15), row = 2 * line + (c16 >> 3), c8 = c16 & 7;
          GLDS16(KT + (((size_t)(bh * 64 + c)) * 512 + 128 * p + row) * 64 + 8 * c8, kp + i * 1024); } }
}
__device__ __forceinline__ void ml_issue_small(const bf16_t* SS, const bf16_t* VT, const float* WI, const float* WK, LAS unsigned char* lds, int ci, int dir, int ch, int bh, int dvblk, int wave, int lane) {
    const int c = dir ? 63 - ci : ci; LAS unsigned char* sm = lds + ML_SMALL + (ci & 1) * ML_SMALL_STRIDE;
    GLDS16(SS + ((size_t)(ch * 64 + c)) * 4096 + wave * 512 + lane * 8, sm + wave * 1024);
    GLDS16(VT + (((size_t)(bh * 64 + c)) * 512 + 64 * dvblk) * 64 + wave * 512 + lane * 8, sm + 8192 + wave * 1024);
    if (wave == 0) GLDS4(WI + (size_t)ch * SEQ + 64 * c + lane, sm + 16384);
    if (wave == 1) GLDS4(WK + (size_t)ch * SEQ + 64 * c + lane, sm + 16640);
}

__device__ __forceinline__ void mlstm_unit(const Args& A, LAS unsigned char* lds, int unit, int tid, int lane, int wave) {
    unsigned char* ws = A.ws;
    const bf16_t *Q = (const bf16_t*)(ws + WS_Q), *KT = (const bf16_t*)(ws + WS_KT), *VT = (const bf16_t*)(ws + WS_VT), *SS = (const bf16_t*)(ws + WS_SS);
    const float *WI = (const float*)(ws + WS_WI), *WK = (const float*)(ws + WS_WK), *DEC = (const float*)(ws + WS_DEC);
    float* DEN = (float*)(ws + WS_DEN);
    const int ch = unit >> 3, dvblk = unit & 7, dir = ch & 1, bh = ch >> 1, b = bh >> 2, h = bh & 3;
    bf16_t* HOUT = (bf16_t*)(ws + (dir ? WS_AQ : WS_K));
    const int g = lane >> 4, r = lane & 15;
    const bool nwave = (wave == 4), compute = (wave < 4) || (wave == 4 && dvblk == 0);
    f32x4 C[32];
#pragma unroll
    for (int i = 0; i < 32; ++i) C[i] = (f32x4){0.f, 0.f, 0.f, 0.f};
    f32x4 hT[4];
#pragma unroll
    for (int m = 0; m < 4; ++m) hT[m] = (f32x4){0.f, 0.f, 0.f, 0.f};
    bf16x8 vw[2]; float dec = 0.f, dec_next = DEC[ch * 64 + (dir ? 63 : 0)];
    ml_issue_small(SS, VT, WI, WK, lds, 0, dir, ch, bh, dvblk, wave, lane);
    ml_issue_piece(Q, KT, lds, 0, dir, b, h, bh, wave, lane);
    VM_WAIT(); __syncthreads();
    for (int ci = 0; ci < 64; ++ci) {
        const int c = dir ? 63 - ci : ci;
        LAS unsigned char* sm = lds + ML_SMALL + (ci & 1) * ML_SMALL_STRIDE;
#pragma unroll
        for (int p = 0; p < 4; ++p) {
            const int step = ci * 4 + p;
            if (step + 1 < 256) ml_issue_piece(Q, KT, lds, step + 1, dir, b, h, bh, wave, lane);
            if (p == 0 && ci + 1 < 64) ml_issue_small(SS, VT, WI, WK, lds, ci + 1, dir, ch, bh, dvblk, wave, lane);
            if (compute) {
                LAS unsigned char* qp = lds + (p & 1) * 32768; LAS unsigned char* kp = qp + 16384;
                if (p == 0) {
                    dec = dec_next; if (ci + 1 < 64) dec_next = DEC[ch * 64 + (dir ? 62 - ci : ci + 1)];
#pragma unroll
                    for (int k2 = 0; k2 < 2; ++k2) {
                        u32x4 vraw;
                        if (nwave) { const unsigned one = (r == 0) ? 0x3F803F80u : 0u; vraw = (u32x4){one, one, one, one}; }
                        else vraw = *(const LAS u32x4*)(sm + 8192 + (16 * wave + r) * 128 + 64 * k2 + 16 * g);
                        const f32x4 w0 = *(const LAS f32x4*)(sm + 16640 + (32 * k2 + 8 * g) * 4), w1 = *(const LAS f32x4*)(sm + 16640 + (32 * k2 + 8 * g + 4) * 4);
                        u32x4 ww; ww.x = cvtpk(bflo(vraw.x) * w0[0], bfhi(vraw.x) * w0[1]); ww.y = cvtpk(bflo(vraw.y) * w0[2], bfhi(vraw.y) * w0[3]);
                        ww.z = cvtpk(bflo(vraw.z) * w1[0], bfhi(vraw.z) * w1[1]); ww.w = cvtpk(bflo(vraw.w) * w1[2], bfhi(vraw.w) * w1[3]);
                        vw[k2] = __builtin_bit_cast(bf16x8, ww); }
                }
#pragma unroll
                for (int ksl = 0; ksl < 4; ++ksl) { const bf16x8 cf = pack8(C[8 * p + 2 * ksl], C[8 * p + 2 * ksl + 1]);
                    const unsigned qb_ = r * 256 + 16 * ((4 * ksl + g) ^ r);
#pragma unroll
                    for (int m = 0; m < 4; ++m) { const bf16x8 qfr = *(const LAS bf16x8*)(qp + qb_ + 4096 * m);
                        hT[m] = MFMA16(cf, qfr, hT[m]); } }
#pragma unroll
                for (int i = 0; i < 8; ++i) { C[8 * p + i] = C[8 * p + i] * dec;
                    const unsigned rl_ = 8 * (r >> 2) + (r & 3) + 4 * (i & 1), ln_ = rl_ >> 1;
#pragma unroll
                    for (int k2 = 0; k2 < 2; ++k2) { const unsigned c16 = (rl_ & 1) * 8 + 4 * k2 + g; const bf16x8 kfr = *(const LAS bf16x8*)(kp + ln_ * 256 + 16 * (c16 ^ (ln_ & 15)) + 4096 * (i >> 1));
                        C[8 * p + i] = MFMA16(kfr, vw[k2], C[8 * p + i]); } }
                if (p == 3) {
#pragma unroll
                    for (int m = 0; m < 4; ++m) { const float wi = *(const LAS float*)(sm + 16384 + (16 * m + r) * 4); hT[m] = hT[m] * wi;
#pragma unroll
                        for (int k2 = 0; k2 < 2; ++k2) { const bf16x8 sf = *(const LAS bf16x8*)(sm + (16 * m + r) * 128 + 64 * k2 + 16 * g);
                            u32x4 vraw;
                            if (nwave) { const unsigned one = (r == 0) ? 0x3F803F80u : 0u; vraw = (u32x4){one, one, one, one}; }
                            else vraw = *(const LAS u32x4*)(sm + 8192 + (16 * wave + r) * 128 + 64 * k2 + 16 * g);
                            hT[m] = MFMA16(__builtin_bit_cast(bf16x8, vraw), sf, hT[m]); }
                        const size_t tok = (size_t)b * SEQ + 64 * c + 16 * m + r;
                        if (nwave) { if (g == 0) DEN[(size_t)ch * SEQ + 64 * c + 16 * m + r] = hT[m][0]; }
                        else { u32x2 w; w.x = cvtpk(hT[m][0], hT[m][1]); w.y = cvtpk(hT[m][2], hT[m][3]); *(u32x2*)(HOUT + tok * D + h * 512 + 64 * dvblk + 16 * wave + 4 * g) = w; }
                        hT[m] = (f32x4){0.f, 0.f, 0.f, 0.f}; }
                }
            }
            VM_WAIT(); __syncthreads();
        }
    }
}

__device__ __forceinline__ void hm_rows(const Args& A, int lane, int gw, int NGW) {
    unsigned char* ws = A.ws;
    const bf16_t *HF = (const bf16_t*)(ws + WS_K), *HB = (const bf16_t*)(ws + WS_AQ), *SO = (const bf16_t*)(ws + WS_SO); bf16_t* HM = (bf16_t*)(ws + WS_Q);
    const float *DEN = (const float*)(ws + WS_DEN), *MR = (const float*)(ws + WS_MR);
    for (int row = gw; row < T; row += NGW) { const int b = row >> 12, s = row & 4095;
#pragma unroll
        for (int h = 0; h < 4; ++h) { const int chf = (b * 4 + h) * 2, chb = chf + 1;
            const float rdf = 1.0f / fmaxf(fabsf(DEN[(size_t)chf * SEQ + s]), __expf(-MR[(size_t)chf * SEQ + s]));
            const float rdb = 1.0f / fmaxf(fabsf(DEN[(size_t)chb * SEQ + s]), __expf(-MR[(size_t)chb * SEQ + s]));
            const size_t off = (size_t)row * D + h * 512 + 8 * lane;
            const u32x4 a = *(const u32x4*)(HF + off), bq = *(const u32x4*)(HB + off), so = *(const u32x4*)(SO + off);
            float v[8]; float ss = 0.f;
#pragma unroll
            for (int j = 0; j < 4; ++j) { v[2 * j] = bflo(a[j]) * rdf + bflo(bq[j]) * rdb; v[2 * j + 1] = bfhi(a[j]) * rdf + bfhi(bq[j]) * rdb; ss += v[2 * j] * v[2 * j] + v[2 * j + 1] * v[2 * j + 1]; }
            const float rs = 1.0f / sqrtf(wave_sum(ss) * (1.0f / 512.0f) + EPS);
            const f32x4 g0 = *(const f32x4*)(A.mnorm_g + h * 512 + 8 * lane), g1 = *(const f32x4*)(A.mnorm_g + h * 512 + 8 * lane + 4);
            u32x4 w;
            w.x = cvtpk(v[0] * rs * g0[0] * bflo(so.x), v[1] * rs * g0[1] * bfhi(so.x)); w.y = cvtpk(v[2] * rs * g0[2] * bflo(so.y), v[3] * rs * g0[3] * bfhi(so.y));
            w.z = cvtpk(v[4] * rs * g1[0] * bflo(so.z), v[5] * rs * g1[1] * bfhi(so.z)); w.w = cvtpk(v[6] * rs * g1[2] * bflo(so.w), v[7] * rs * g1[3] * bfhi(so.w));
            *(u32x4*)(HM + off) = w; } }
}

__device__ __forceinline__ void rms2_rows(const Args& A, int lane, int gw, int NGW) {
    bf16_t* XN2 = (bf16_t*)(A.ws + WS_Q);
    f32x4 gv[8];
#pragma unroll
    for (int j = 0; j < 8; ++j) gv[j] = *(const f32x4*)(A.norm2_g + 4 * lane + 256 * j);
    for (int row = gw; row < T; row += NGW) {
        f32x4 v[8]; float ss = 0.f;
#pragma unroll
        for (int j = 0; j < 8; ++j) { v[j] = *(const f32x4*)(A.out + (size_t)row * D + 4 * lane + 256 * j); ss += (v[j][0] * v[j][0] + v[j][1] * v[j][1]) + (v[j][2] * v[j][2] + v[j][3] * v[j][3]); }
        const float rstd = 1.0f / sqrtf(wave_sum(ss) * (1.0f / D) + EPS);
#pragma unroll
        for (int j = 0; j < 8; ++j) { const f32x4 o = v[j] * rstd * gv[j]; u32x2 w; w.x = cvtpk(o[0], o[1]); w.y = cvtpk(o[2], o[3]); *(u32x2*)(XN2 + (size_t)row * D + 4 * lane + 256 * j) = w; }
    }
}

__device__ __forceinline__ unsigned f2ord(float f) { const unsigned u = __float_as_uint(f); return u ^ ((u >> 31) ? 0xFFFFFFFFu : 0x80000000u); }
__device__ __forceinline__ float ord2f(unsigned k) { const unsigned u = (k & 0x80000000u) ? (k ^ 0x80000000u) : ~k; return __uint_as_float(u); }
#define INS16(L, xin) do { unsigned _x = (xin); _Pragma("unroll") for (int _i = 0; _i < 16; ++_i) { const unsigned _hi = max(L[_i], _x); _x = min(L[_i], _x); L[_i] = _hi; } } while (0)

__device__ __forceinline__ void topk_unit(const Args& A, LAS unsigned char* lds, int unit, int lane, int wave) {
    unsigned char* ws = A.ws;
    const bf16_t *PQ = (const bf16_t*)(ws + WS_XN), *KEYS = (const bf16_t*)(ws + WS_KEYS);
    int* EXPI = (int*)(ws + WS_EXP); float* GATE = (float*)(ws + WS_GATE);
    const int h = unit & 7, tg = unit >> 3, t0 = tg * 32, tl = lane & 31, hh = lane >> 5;
    LAS unsigned* lw = (LAS unsigned*)(lds + wave * 8192);
    unsigned L0[16], L1[16];
#pragma unroll
    for (int p = 0; p < 2; ++p) {
        f32x16 acc[4];
#pragma unroll
        for (int nb = 0; nb < 4; ++nb)
#pragma unroll
            for (int e = 0; e < 16; ++e) acc[nb][e] = 0.f;
#pragma unroll 2
        for (int ks = 0; ks < 8; ++ks) { const bf16x8 bq = *(const bf16x8*)(PQ + (size_t)(t0 + tl) * D + h * 256 + p * 128 + 16 * ks + 8 * hh);
#pragma unroll
            for (int nb = 0; nb < 4; ++nb) { const bf16x8 ak = *(const bf16x8*)(KEYS + ((size_t)(h * 2 + p) * 128 + 32 * nb + tl) * 128 + 16 * ks + 8 * hh);
                acc[nb] = __builtin_amdgcn_mfma_f32_32x32x16_bf16(ak, bq, acc[nb], 0, 0, 0); } }
        unsigned L[16];
#pragma unroll
        for (int i = 0; i < 16; ++i) L[i] = 0u;
#pragma unroll
        for (int nb = 0; nb < 4; ++nb)
#pragma unroll
            for (int e = 0; e < 16; ++e) { const unsigned n = 32 * nb + (e & 3) + 8 * (e >> 2) + 4 * hh; const unsigned key = (f2ord(acc[nb][e]) & ~127u) | (127u - n); INS16(L, key); }
        unsigned M[16];
#pragma unroll
        for (int i = 0; i < 16; ++i) M[i] = max(L[i], (unsigned)__shfl_xor(L[15 - i], 32));
#pragma unroll
        for (int st = 8; st >= 1; st >>= 1)
#pragma unroll
            for (int i = 0; i < 16; ++i) if ((i & st) == 0) { const unsigned a = M[i], b2 = M[i + st]; M[i] = max(a, b2); M[i + st] = min(a, b2); }
#pragma unroll
        for (int i = 0; i < 16; ++i) L[i] = M[i];
#pragma unroll
        for (int i = 0; i < 16; ++i) { if (p == 0) L0[i] = L[i]; else L1[i] = L[i]; }
    }
    float v0[16], v1[16];
#pragma unroll
    for (int i = 0; i < 16; ++i) { v0[i] = ord2f(L0[i] & ~127u); v1[i] = ord2f(L1[i] & ~127u); lw[i * 64 + lane] = 127u - (L0[i] & 127u); lw[(16 + i) * 64 + lane] = 127u - (L1[i] & 127u); }
    unsigned Cn[16];
#pragma unroll
    for (int i = 0; i < 16; ++i) Cn[i] = 0u;
#pragma unroll
    for (int i = 0; i < 16; ++i)
#pragma unroll
        for (int j = 0; j < 16; ++j) if ((i + 1) * (j + 1) <= 16) { const unsigned key = (f2ord(v0[i] + v1[j]) & ~255u) | (255u - (unsigned)(i * 16 + j)); INS16(Cn, key); }
    float cv[16]; float sum = 0.f;
    const float m0 = ord2f(Cn[0] & ~255u);
#pragma unroll
    for (int rr = 0; rr < 16; ++rr) { cv[rr] = __expf(ord2f(Cn[rr] & ~255u) - m0); sum += cv[rr]; }
    const float rs = 1.0f / sum;
    if (hh == 0) {
        const size_t o = (size_t)(t0 + tl) * 128 + h * 16;
#pragma unroll
        for (int rr = 0; rr < 16; ++rr) { const unsigned code = 255u - (Cn[rr] & 255u), i = code >> 4, j = code & 15u;
            const unsigned e1 = lw[i * 64 + lane], e2 = lw[(16 + j) * 64 + lane];
            EXPI[o + rr] = (int)(e1 * 128u + e2); GATE[o + rr] = cv[rr] * rs; }
    }
}


#ifdef DBG_NAIVE9
__device__ __forceinline__ void topk_naive(const Args& A, int gid) {
    unsigned char* ws = A.ws;
    const bf16_t *PQ = (const bf16_t*)(ws + WS_XN), *KEYS = (const bf16_t*)(ws + WS_KEYS);
    int* EXPI = (int*)(ws + WS_EXP); float* GATE = (float*)(ws + WS_GATE);
    const int t = gid >> 3, h = gid & 7;
    float bv[2][16]; int bi[2][16];
#pragma unroll
    for (int p = 0; p < 2; ++p) {
#pragma unroll
        for (int i = 0; i < 16; ++i) { bv[p][i] = -3.0e38f; bi[p][i] = 0; }
        for (int n = 0; n < 128; ++n) { float dot = 0.f;
            for (int d = 0; d < 128; ++d) dot += __uint_as_float((unsigned)PQ[(size_t)t * D + h * 256 + p * 128 + d] << 16) * __uint_as_float((unsigned)KEYS[((size_t)(h * 2 + p) * 128 + n) * 128 + d] << 16);
            float x = dot; int xi = n;
#pragma unroll
            for (int i = 0; i < 16; ++i) { if (x > bv[p][i]) { const float tv = bv[p][i]; const int ti = bi[p][i]; bv[p][i] = x; bi[p][i] = xi; x = tv; xi = ti; } } }
    }
    float cv[16]; int ci[16];
#pragma unroll
    for (int i = 0; i < 16; ++i) { cv[i] = -3.0e38f; ci[i] = 0; }
#pragma unroll
    for (int i = 0; i < 16; ++i)
#pragma unroll
        for (int j = 0; j < 16; ++j) { float x = bv[0][i] + bv[1][j]; int xi = bi[0][i] * 128 + bi[1][j];
#pragma unroll
            for (int k = 0; k < 16; ++k) { if (x > cv[k]) { const float tv = cv[k]; const int ti = ci[k]; cv[k] = x; ci[k] = xi; x = tv; xi = ti; } } }
    float sum = 0.f; const float m0 = cv[0];
#pragma unroll
    for (int k = 0; k < 16; ++k) { cv[k] = __expf(cv[k] - m0); sum += cv[k]; }
#pragma unroll
    for (int k = 0; k < 16; ++k) { EXPI[(size_t)t * 128 + h * 16 + k] = ci[k]; GATE[(size_t)t * 128 + h * 16 + k] = cv[k] / sum; }
}
#endif

__device__ __forceinline__ float gelu_erf(float v) { return 0.5f * v * (1.0f + erff(v * 0.70710678118654752f)); }
__device__ __forceinline__ float dot8(const u32x4 a, const u32x4 b, float acc) {
#pragma unroll
    for (int j = 0; j < 4; ++j) { const unsigned av = a[j], bv = b[j];
        acc = __builtin_amdgcn_fdot2_f32_bf16(__builtin_bit_cast(bf2_t, av), __builtin_bit_cast(bf2_t, bv), acc, false); }
    return acc;
}
__device__ __forceinline__ void gather_tokens(const Args& A, int lane, int gw, int NGW) {
    unsigned char* ws = A.ws;
    const bf16_t *XN2 = (const bf16_t*)(ws + WS_Q), *PU = (const bf16_t*)(ws + WS_KT), *PV = (const bf16_t*)(ws + WS_VT);
    const int* EXPI = (const int*)(ws + WS_EXP); const float* GATE = (const float*)(ws + WS_GATE);
    for (int t = gw; t < T; t += NGW) {
        u32x4 xr[4];
#pragma unroll
        for (int j = 0; j < 4; ++j) xr[j] = *(const u32x4*)(XN2 + (size_t)t * D + 8 * lane + 512 * j);
        const int id0 = EXPI[(size_t)t * 128 + lane], id1 = EXPI[(size_t)t * 128 + 64 + lane];
        const float gt0 = GATE[(size_t)t * 128 + lane], gt1 = GATE[(size_t)t * 128 + 64 + lane];
        float o[32];
#pragma unroll
        for (int i = 0; i < 32; ++i) o[i] = 0.f;
        for (int bb = 0; bb < 16; ++bb) {
            const int idv = bb < 8 ? id0 : id1; const float gtv = bb < 8 ? gt0 : gt1; const int lb = (bb & 7) * 8;
            float part[8];
#pragma unroll
            for (int e = 0; e < 8; ++e) { const int id = __builtin_amdgcn_readlane(idv, lb + e); const bf16_t* urow = PU + (size_t)id * D + 8 * lane; float a = 0.f;
#pragma unroll
                for (int j = 0; j < 4; ++j) a = dot8(*(const u32x4*)(urow + 512 * j), xr[j], a);
                part[e] = a; }
#pragma unroll
            for (int i = 0; i < 4; ++i) { const float send = (lane & 1) ? part[i] : part[i + 4], keep = (lane & 1) ? part[i + 4] : part[i]; part[i] = keep + __shfl_xor(send, 1); }
#pragma unroll
            for (int i = 0; i < 2; ++i) { const float send = (lane & 2) ? part[i] : part[i + 2], keep = (lane & 2) ? part[i + 2] : part[i]; part[i] = keep + __shfl_xor(send, 2); }
            { const float send = (lane & 4) ? part[0] : part[1], keep = (lane & 4) ? part[1] : part[0]; part[0] = keep + __shfl_xor(send, 4); }
            float dt = part[0]; dt += __shfl_xor(dt, 8); dt += __shfl_xor(dt, 16); dt += __shfl_xor(dt, 32);
            const int el = ((lane & 1) << 2) | (lane & 2) | ((lane & 4) >> 2);
            const float act = gelu_erf(dt) * __shfl(gtv, lb + el);
#pragma unroll
            for (int e = 0; e < 8; ++e) { const int src = ((e & 4) >> 2) | (e & 2) | ((e & 1) << 2);
                const float a = __builtin_bit_cast(float, __builtin_amdgcn_readlane(__builtin_bit_cast(int, act), src));
                const int id = __builtin_amdgcn_readlane(idv, lb + e); const bf16_t* vrow = PV + (size_t)id * D + 8 * lane;
#pragma unroll
                for (int j = 0; j < 4; ++j) { const u32x4 vv = *(const u32x4*)(vrow + 512 * j);
#pragma unroll
                    for (int q = 0; q < 4; ++q) { o[8 * j + 2 * q] += a * bflo(vv[q]); o[8 * j + 2 * q + 1] += a * bfhi(vv[q]); } } }
        }
#pragma unroll
        for (int j = 0; j < 4; ++j) { float* op = A.out + (size_t)t * D + 8 * lane + 512 * j;
            f32x4 a = *(const f32x4*)op, b2 = *(const f32x4*)(op + 4);
            a[0] += o[8 * j]; a[1] += o[8 * j + 1]; a[2] += o[8 * j + 2]; a[3] += o[8 * j + 3]; b2[0] += o[8 * j + 4]; b2[1] += o[8 * j + 5]; b2[2] += o[8 * j + 6]; b2[3] += o[8 * j + 7];
            *(f32x4*)op = a; *(f32x4*)(op + 4) = b2; }
    }
}


#ifdef DBG_NAIVE10
__device__ __forceinline__ void gather_naive(const Args& A, LAS unsigned char* lds, int t, int tid) {
    unsigned char* ws = A.ws;
    const bf16_t *XN2 = (const bf16_t*)(ws + WS_Q), *PU = (const bf16_t*)(ws + WS_KT), *PV = (const bf16_t*)(ws + WS_VT);
    const int* EXPI = (const int*)(ws + WS_EXP); const float* GATE = (const float*)(ws + WS_GATE);
    LAS float* act = (LAS float*)lds; LAS int* ids = (LAS int*)(lds + 1024);
    if (tid < 128) { const int id = EXPI[(size_t)t * 128 + tid]; float dot = 0.f;
        for (int d = 0; d < D; ++d) dot += __uint_as_float((unsigned)XN2[(size_t)t * D + d] << 16) * __uint_as_float((unsigned)PU[(size_t)id * D + d] << 16);
        act[tid] = 0.5f * dot * (1.0f + erff(dot * 0.70710678118654752f)) * GATE[(size_t)t * 128 + tid]; ids[tid] = id; }
    __syncthreads();
    for (int d = tid; d < D; d += NTHR) { float acc = 0.f;
        for (int k = 0; k < 128; ++k) acc += act[k] * __uint_as_float((unsigned)PV[(size_t)ids[k] * D + d] << 16);
        A.out[(size_t)t * D + d] += acc; }
    __syncthreads();
}
#endif

__global__ void __launch_bounds__(NTHR, 2) fwd_kernel(Args A) {
    extern __shared__ __attribute__((aligned(16))) unsigned char lds_raw[];
    LAS unsigned char* lds = (LAS unsigned char*)lds_raw;
    const int tid = threadIdx.x, lane = tid & 63, wave = __builtin_amdgcn_readfirstlane(tid >> 6);
    const int G = gridDim.x, bx = blockIdx.x;
    const int vcu = (G % 8 == 0) ? (bx % 8) * (G / 8) + bx / 8 : bx;
    const int gw = bx * NWAVES + wave, NGW = G * NWAVES;
    unsigned char* ws = A.ws;
    volatile LAS unsigned* MISC = (volatile LAS unsigned*)(lds + MISC_OFF);
    if (tid < 16) MISC[tid] = 0u;
    __syncthreads();
    const int lo = A.ph_lo, hi = A.ph_hi;
    XcdBarrier bar; bar.bar = (unsigned*)(ws + WS_CTL) + CW_BAR; bar.x = 0; bar.st = nullptr;
    if (hi - lo > 1) bar = xcd_barrier_post((unsigned*)(ws + WS_CTL) + CW_BAR, MISC + 8);
#ifndef ONLY_PHASE
#define ONLY_PHASE -1
#endif
#define IN(k) ((ONLY_PHASE < 0 || ONLY_PHASE == (k)) && lo <= (k) && (k) < hi)
#define SEAM(k) do { if (IN(k) && IN((k) + 1)) xcd_barrier(bar); } while (0)

    if (IN(0)) { p0_prologue(A, lds, tid, lane, wave, G); }
    SEAM(0);
    if (IN(1)) {
        if (bx < 32) gate_scan(A, lds, bx, tid, lane, wave);
        pg8::Gemm g{(const bf16_t*)(ws + WS_XN), (const bf16_t*)(ws + WS_WIN), T, NIN, D}; pg8::StaticOrder S; S.init(T, NIN, G, bx);
        EpiInProj E{(bf16_t*)(ws + WS_Q), (bf16_t*)(ws + WS_K), (bf16_t*)(ws + WS_KT), (bf16_t*)(ws + WS_VT), (bf16_t*)(ws + WS_SO), (bf16_t*)(ws + WS_AQ), (bf16_t*)(ws + WS_AK), (bf16_t*)(ws + WS_AV),
                    (bf16_t*)A.out, (bf16_t*)A.out + (size_t)T * D};
        pg8::gemm_phase<EpiInProj, pg8::StaticOrder, false>(lds, g, S, E, nullptr);
    }
    SEAM(1);
    if (IN(2)) {
        for (int u = vcu; u < 2048; u += G) attn_unit(A, lds, u, tid, lane, wave);
        for (int u = vcu; u < 1024; u += G) ss_unit(A, u, lane, wave);
        __syncthreads();
        LAS float* scr = (LAS float*)(lds + wave * 8704);
        constexpr int NBLK = D / 32, NIT = (D / 64) * NBLK;
        for (int it = gw; it < 4 * NIT; it += NGW) { const int w = it / NIT, r = it % NIT;
            const float* src = w == 0 ? A.w_a : w == 1 ? A.w_m : w == 2 ? A.w_out : A.peer_wq;
            bf16_t* dst = (bf16_t*)(ws + (w == 0 ? WS_WA : w == 1 ? WS_WM : w == 2 ? WS_WO : WS_WQ));
            transpose_item(src, D, D, NBLK, dst, scr, r, lane, false); }
        convert_stream(A.peer_keys, (bf16_t*)(ws + WS_KEYS), (size_t)16 * 128 * 128, bx * NTHR + tid, G * NTHR);
    }
    SEAM(2);
    if (IN(3)) { for (int u = vcu; u < 256; u += G) mlstm_unit(A, lds, u, tid, lane, wave); }
    SEAM(3);
    if (IN(4)) {
        hm_rows(A, lane, gw, NGW);
        convert_stream(A.peer_u, (bf16_t*)(ws + WS_KT), (size_t)16384 * D, bx * NTHR + tid, G * NTHR);
        convert_stream(A.peer_v, (bf16_t*)(ws + WS_VT), (size_t)16384 * D, bx * NTHR + tid, G * NTHR);
    }
    SEAM(4);
    if (IN(5)) {
        pg8::StaticOrder S; S.init(T, D, G, bx);
        { pg8::Gemm g{(const bf16_t*)(ws + WS_XN), (const bf16_t*)(ws + WS_WA), T, D, D}; EpiGateF32 E{(const bf16_t*)A.out + (size_t)T * D, (float*)(ws + WS_TMP)};
          pg8::gemm_phase<EpiGateF32, pg8::StaticOrder, false>(lds, g, S, E, nullptr); }
        { pg8::Gemm g{(const bf16_t*)(ws + WS_Q), (const bf16_t*)(ws + WS_WM), T, D, D}; EpiMerge E{(const bf16_t*)A.out, (const float*)(ws + WS_TMP), (bf16_t*)(ws + WS_SO)};
          pg8::gemm_phase<EpiMerge, pg8::StaticOrder, false>(lds, g, S, E, nullptr); }
    }
    SEAM(5);
    if (IN(6)) {
        pg8::StaticOrder S; S.init(T, D, G, bx);
        pg8::Gemm g{(const bf16_t*)(ws + WS_SO), (const bf16_t*)(ws + WS_WO), T, D, D}; EpiResid E{A.x, A.out};
        pg8::gemm_phase<EpiResid, pg8::StaticOrder, false>(lds, g, S, E, nullptr);
    }
    SEAM(6);
    if (IN(7)) { rms2_rows(A, lane, gw, NGW); }
    SEAM(7);
    if (IN(8)) {
        pg8::StaticOrder S; S.init(T, D, G, bx);
        pg8::Gemm g{(const bf16_t*)(ws + WS_Q), (const bf16_t*)(ws + WS_WQ), T, D, D}; EpiPlainBf16 E{(bf16_t*)(ws + WS_XN)};
        pg8::gemm_phase<EpiPlainBf16, pg8::StaticOrder, false>(lds, g, S, E, nullptr);
    }
    SEAM(8);
#ifdef DBG_NAIVE9
    if (IN(9)) { for (int gid = bx * NTHR + tid; gid < T * 8; gid += G * NTHR) topk_naive(A, gid); }
#else
    if (IN(9)) { for (int u = gw; u < 4096; u += NGW) topk_unit(A, lds, u, lane, wave); }
#endif
    SEAM(9);
#ifdef DBG_NAIVE10
    if (IN(10)) { for (int t = bx; t < T; t += G) gather_naive(A, lds, t, tid); }
#else
    if (IN(10)) { gather_tokens(A, lane, gw, NGW); }
#endif
}

#ifndef N_LAUNCHES
#define N_LAUNCHES 11
#endif
extern "C" void kernel_launch(void* const* d_in, const int* in_sizes, int n_in, void* d_out, int out_size, void* d_ws, size_t ws_size, hipStream_t stream) {
    static int grid = 0;
    if (grid == 0) {
        if (n_in != 17 || in_sizes[0] != T * D || out_size != T * D || ws_size < WS_END) { fprintf(stderr, "kernel_launch: unexpected shapes (n_in %d, in0 %d, out %d, ws %zu): nothing launched\n", n_in, n_in > 0 ? in_sizes[0] : -1, out_size, ws_size); grid = -1; return; }
        int dev = 0, cus = 0, per_cu = 0;
        if (hipGetDevice(&dev) != hipSuccess || hipDeviceGetAttribute(&cus, hipDeviceAttributeMultiprocessorCount, dev) != hipSuccess) { grid = -1; return; }
        if (hipFuncSetAttribute((const void*)fwd_kernel, hipFuncAttributeMaxDynamicSharedMemorySize, LDS_BYTES) != hipSuccess) { fprintf(stderr, "kernel_launch: hipFuncSetAttribute failed\n"); grid = -1; return; }
        if (hipOccupancyMaxActiveBlocksPerMultiprocessor(&per_cu, (const void*)fwd_kernel, NTHR, LDS_BYTES) != hipSuccess || per_cu < 1) { fprintf(stderr, "kernel_launch: occupancy query reports %d\n", per_cu); }
        (void)hipGetLastError();
        grid = cus;
    }
    if (grid < 0) return;
    if (hipMemsetAsync((char*)d_ws + WS_CTL, 0, CTL_ZERO_BYTES, stream) != hipSuccess) return;
    Args a{};
    a.x = (const float*)d_in[0]; a.norm1_g = (const float*)d_in[1]; a.w_in = (const float*)d_in[2]; a.gate_b = (const float*)d_in[3]; a.mnorm_g = (const float*)d_in[4]; a.w_m = (const float*)d_in[5];
    a.gq = (const float*)d_in[6]; a.gk = (const float*)d_in[7]; a.sink = (const float*)d_in[8]; a.rel_bias = (const float*)d_in[9]; a.w_a = (const float*)d_in[10]; a.w_out = (const float*)d_in[11];
    a.norm2_g = (const float*)d_in[12]; a.peer_wq = (const float*)d_in[13]; a.peer_keys = (const float*)d_in[14]; a.peer_u = (const float*)d_in[15]; a.peer_v = (const float*)d_in[16];
    a.out = (float*)d_out; a.ws = (unsigned char*)d_ws;
#ifndef DBG_LAST
#define DBG_LAST (NPHASE - 1)
#endif
    for (int li = 0; li < N_LAUNCHES && li <= DBG_LAST; ++li) {
        a.ph_lo = (N_LAUNCHES == 1) ? 0 : li; a.ph_hi = (N_LAUNCHES == 1) ? NPHASE : li + 1;
        hipLaunchKernelGGL(fwd_kernel, dim3(grid), dim3(NTHR), LDS_BYTES, stream, a);
    }
}
```

```cpp
#include <hip/hip_runtime.h>
#include <cstdio>

namespace pg8 {
#define PG8_LAS __attribute__((address_space(3)))
typedef unsigned short bf16_t;
typedef short bf16x8 __attribute__((ext_vector_type(8)));
typedef float f32x4 __attribute__((ext_vector_type(4)));
typedef unsigned u32x4 __attribute__((ext_vector_type(4)));
constexpr int BM = 256, BK = 64, HALF = 128, HTB = HALF * BK * 2  , STAGE_BYTES = 8 * HTB, NXCD = 8, WGM = 8;

__host__ __device__ __forceinline__ int lds_byte(int r, int c) { const int st = (r >> 4) * 2 + (c >> 5), rr = r & 15, cc = c & 31, ob = rr * 64 + cc * 2; return st * 1024 + (ob ^ (((ob >> 9) & 1) << 5)); }
__host__ __device__ __forceinline__ void stage_rc(int b, int& R, int& C) { const int st = b / 1024, sb = b % 1024, swz = sb ^ (((sb >> 9) & 1) << 5); R = (st >> 1) * 16 + swz / 64; C = (st & 1) * 32 + (swz % 64) / 2; }
__host__ __device__ __forceinline__ int perm32(int rho) { const int n = rho >> 4, i = rho & 15; return 8 * (i >> 2) + 4 * n + (i & 3); }

struct Unit { int pm, pn; };
struct Gemm { const bf16_t* A; const bf16_t* Bt; int M, N, K; const bf16_t* A2 = nullptr; const bf16_t* Bt2 = nullptr; };

struct StaticOrder {
    int nM, nN, nwg, G, c;
    __host__ __device__ void init(int M, int N, int G_, int c_) { nM = M / BM; nN = N / BM; nwg = nM * nN; G = G_; c = c_; }
    __host__ __device__ bool next(int i, Unit& u) const {
        const long L = (long)i * G + c; if (L >= nwg) return false;
        int wgid = (int)L; { const int q = nwg / NXCD, r = nwg % NXCD, xcd = wgid % NXCD, off = wgid / NXCD; wgid = (xcd < r ? xcd * (q + 1) : r * (q + 1) + (xcd - r) * q) + off; }
        const int nig = WGM * nN, gid = wgid / nig, fm = gid * WGM, gsz = (nM - fm) < WGM ? (nM - fm) : WGM;
        u.pm = fm + ((wgid % nig) % gsz); u.pn = (wgid % nig) / gsz; return true;
    }
    __device__ __forceinline__ void a_ready(const Unit&) const {}
    __device__ __forceinline__ void done(const Unit&) const {}
};
struct CountedOrder : StaticOrder {
    const unsigned* ready; unsigned need; unsigned* tmo;
    __device__ __forceinline__ void a_ready(const Unit& u) const {
        if (threadIdx.x < 64) {
            const unsigned long long t0 = __builtin_amdgcn_s_memrealtime(); unsigned polls = 0;
            while ((unsigned)__builtin_amdgcn_readfirstlane(__hip_atomic_load(ready + 64 * u.pm, __ATOMIC_RELAXED, __HIP_MEMORY_SCOPE_AGENT)) < need) {
                if ((++polls & 255u) == 0u && __builtin_amdgcn_readfirstlane(__hip_atomic_load(tmo, __ATOMIC_RELAXED, __HIP_MEMORY_SCOPE_AGENT)) != 0u) break;
                if (__builtin_amdgcn_s_memrealtime() - t0 > 2000000ull) {
                    if (threadIdx.x == 0) { unsigned expect = 0u; __hip_atomic_compare_exchange_strong(tmo + 1, &expect, 0x600u | (unsigned)(u.pm & 0xff), __ATOMIC_RELAXED, __ATOMIC_RELAXED, __HIP_MEMORY_SCOPE_AGENT); __hip_atomic_store(tmo, 1u, __ATOMIC_RELAXED, __HIP_MEMORY_SCOPE_AGENT); }
                    break; }
                __builtin_amdgcn_s_sleep(2); }
            __builtin_amdgcn_fence(__ATOMIC_ACQUIRE, "agent");
            asm volatile("s_waitcnt vmcnt(0)" ::: "memory");
        }
#if !defined(BROKEN_HOOK_NO_BARRIER)
        asm volatile("" ::: "memory"); __builtin_amdgcn_s_barrier(); asm volatile("" ::: "memory");
#endif
    }
};

__device__ __forceinline__ unsigned cvt_pk_bf16(float lo, float hi) { unsigned r; asm volatile("v_cvt_pk_bf16_f32 %0, %1, %2" : "=v"(r) : "v"(lo), "v"(hi)); return r; }
typedef float f32x2 __attribute__((ext_vector_type(2)));
__device__ __forceinline__ f32x2 gelu_pk(f32x2 v) {
    const f32x2 av = __builtin_elementwise_abs(v), d = av * 0.2316418882f + 1.0f;
    f32x2 t; t.x = __builtin_amdgcn_rcpf(d.x); t.y = __builtin_amdgcn_rcpf(d.y);
    f32x2 q = t * 0.5307027145f + (-0.7265760135f); q = q * t + 0.7107068705f; q = q * t + (-0.142248368f); q = q * t + 0.127414796f; q = q * t;
    const f32x2 s = (v * v) * (-0.72134752044f);
    f32x2 e; e.x = __builtin_amdgcn_exp2f(s.x); e.y = __builtin_amdgcn_exp2f(s.y);
    const f32x2 m = v * (q * e), r = v - m;
    f32x2 o; o.x = v.x < 0.f ? m.x : r.x; o.y = v.y < 0.f ? m.y : r.y; return o;
}

typedef int i32x4 __attribute__((ext_vector_type(4)));
typedef int i32x8 __attribute__((ext_vector_type(8)));
template <class Epi, class Sched, bool STAMP = false, bool F8 = false>
__device__ __forceinline__ void gemm_phase(PG8_LAS unsigned char* lds, const Gemm g, const Sched& S, const Epi& E, unsigned long long* stamps) {
    const int tid = threadIdx.x, wid = __builtin_amdgcn_readfirstlane(tid >> 6), lane = tid & 63, wr = wid >> 2, wc = wid & 3, fr = lane & 15, fq = lane >> 4;
    const int K = g.K, nth = K / BK, nt = Epi::HAS_MID ? 2 * nth : nth;
    int ts_lo = 0, ts_hi = 0, nts = 0; const unsigned long long rt_entry = STAMP ? (unsigned long long)wall_clock64() : 0ull;
#define PG8_STAMP() do { if (STAMP && wid == 0 && nts < 64) { const unsigned long long _c = (unsigned long long)clock64(); \
        ts_lo = (lane == nts) ? (int)(unsigned)_c : ts_lo; ts_hi = (lane == nts) ? (int)(unsigned)(_c >> 32) : ts_hi; ++nts; } } while (0)
    PG8_STAMP();
    unsigned voffA[2], voffB[2];
#pragma unroll
    for (int i = 0; i < 2; ++i) { int R, C; stage_rc(tid * 16 + i * 8192, R, C); const int Rb = Epi::PERM ? ((R & ~31) + perm32(R & 31)) : R;
        voffA[i] = (unsigned)(R * K + C) * 2u; voffB[i] = (unsigned)(Rb * K + C) * 2u; }
    const size_t kstep = (size_t)(BK * 2);
    const size_t hstep = (size_t)HALF * K * 2;
    const size_t tstep = 2 * hstep;
    const unsigned ldsw = (unsigned)wid * 1024u;
    const int aoff = lds_byte(wr * 64 + fr, fq * (F8 ? 16 : 8)), boff = lds_byte(wc * 32 + fr, fq * (F8 ? 16 : 8));
#define PG8_SA(b, h) (((b) * 2 + (h)) * HTB)
#define PG8_SB(b, h) ((4 + (b) * 2 + (h)) * HTB)
#define PG8_STAGE(bufoff, gbase, voff) do { _Pragma("unroll") for (int _i = 0; _i < 2; ++_i) \
        __builtin_amdgcn_global_load_lds((const unsigned*)((const char*)(gbase) + (voff)[_i]), (PG8_LAS unsigned*)(lds + (bufoff) + ldsw + _i * 8192), 16, 0, 0); } while (0)
#define PG8_CAT8(lo, hi) __builtin_shufflevector(__builtin_bit_cast(i32x4, lo), __builtin_bit_cast(i32x4, hi), 0, 1, 2, 3, 4, 5, 6, 7)
#define PG8_LDA(dst, b, h) do { if constexpr (F8) { _Pragma("unroll") for (int m = 0; m < 4; ++m) dst##8[m] = PG8_CAT8(*(const PG8_LAS bf16x8*)(lds + PG8_SA(b, h) + aoff + m * 2048), *(const PG8_LAS bf16x8*)(lds + PG8_SA(b, h) + aoff + m * 2048 + 16)); } \
        else { _Pragma("unroll") for (int m = 0; m < 4; ++m) _Pragma("unroll") for (int k = 0; k < 2; ++k) dst[m][k] = *(const PG8_LAS bf16x8*)(lds + PG8_SA(b, h) + aoff + m * 2048 + k * 1024); } } while (0)
#define PG8_LDB(dst, b, h) do { if constexpr (F8) { _Pragma("unroll") for (int n = 0; n < 2; ++n) dst##8[n] = PG8_CAT8(*(const PG8_LAS bf16x8*)(lds + PG8_SB(b, h) + boff + n * 2048), *(const PG8_LAS bf16x8*)(lds + PG8_SB(b, h) + boff + n * 2048 + 16)); } \
        else { _Pragma("unroll") for (int n = 0; n < 2; ++n) _Pragma("unroll") for (int k = 0; k < 2; ++k) dst[n][k] = *(const PG8_LAS bf16x8*)(lds + PG8_SB(b, h) + boff + n * 2048 + k * 1024); } } while (0)
#define PG8_MMA(ai, bj, At, Bt) do { __builtin_amdgcn_s_setprio(1); \
        if constexpr (F8) { _Pragma("unroll") for (int m = 0; m < 4; ++m) _Pragma("unroll") for (int n = 0; n < 2; ++n) \
            asm volatile("s_nop 1\n\tv_mfma_f32_16x16x128_f8f6f4 %0, %1, %2, %0" : "+v"(acc[ai][bj][m][n]) : "v"(Bt##8[n]), "v"(At##8[m])); }   \
        else { _Pragma("unroll") for (int m = 0; m < 4; ++m) _Pragma("unroll") for (int n = 0; n < 2; ++n) _Pragma("unroll") for (int k = 0; k < 2; ++k) \
            acc[ai][bj][m][n] = __builtin_amdgcn_mfma_f32_16x16x32_bf16(Bt[n][k], At[m][k], acc[ai][bj][m][n], 0, 0, 0); } \
        __builtin_amdgcn_s_setprio(0); } while (0)
#define PG8_WAIT_V(n) asm volatile("s_waitcnt vmcnt(" #n ")" ::: "memory")
#define PG8_WAIT_L(n) asm volatile("s_waitcnt lgkmcnt(" #n ")" ::: "memory")
#define PG8_BAR __builtin_amdgcn_s_barrier()
#define PG8_SCHED __builtin_amdgcn_sched_barrier(0)
    Unit cur, nxt; int ui = 0;
    if (!S.next(0, cur)) return;
    f32x4 acc[2][2][4][2];
#pragma unroll
    for (int a = 0; a < 2; ++a)
#pragma unroll
        for (int b = 0; b < 2; ++b)
#pragma unroll
            for (int m = 0; m < 4; ++m)
#pragma unroll
                for (int n = 0; n < 2; ++n) acc[a][b][m][n] = (f32x4){0.f, 0.f, 0.f, 0.f};
    bf16x8 At[4][2], B0[2][2], B1[2][2]; i32x8 At8[4], B08[2], B18[2];
    const char* cA = (const char*)g.A + (size_t)cur.pm * tstep; const char* cB = (const char*)g.Bt + (size_t)cur.pn * tstep;
    const char* cA2 = Epi::HAS_MID ? (const char*)g.A2 + (size_t)cur.pm * tstep : cA; const char* cB2 = Epi::HAS_MID ? (const char*)g.Bt2 + (size_t)cur.pn * tstep : cB;
#define PG8_TP(c1, c2, tt) ((Epi::HAS_MID && (tt) >= nth) ? (c2) + (size_t)((tt) - nth) * kstep : (c1) + (size_t)(tt) * kstep)
    S.a_ready(cur);
    PG8_STAGE(PG8_SB(0, 0), cB, voffB); PG8_STAGE(PG8_SA(0, 0), cA, voffA); PG8_STAGE(PG8_SB(0, 1), cB + hstep, voffB); PG8_STAGE(PG8_SA(0, 1), cA + hstep, voffA);
    if (wr == 1) PG8_BAR;
    PG8_WAIT_V(4); PG8_BAR;
    PG8_STAGE(PG8_SB(1, 0), cB + kstep, voffB); PG8_STAGE(PG8_SA(1, 0), cA + kstep, voffA); PG8_STAGE(PG8_SB(1, 1), cB + hstep + kstep, voffB);
    PG8_WAIT_V(6); PG8_BAR;
    PG8_STAMP();
    for (;;) {
        const bool has_next = S.next(ui + 1, nxt);
        const char* nA = has_next ? (const char*)g.A + (size_t)nxt.pm * tstep : cA; const char* nB = has_next ? (const char*)g.Bt + (size_t)nxt.pn * tstep : cB;
        for (int t = 0; t < nt; t += 2) {
            const bool last = (t == nt - 2);
            const char* a1 = PG8_TP(cA, cA2, t + 1);
            const char* a2 = last ? nA : PG8_TP(cA, cA2, t + 2); const char* b2 = last ? nB : PG8_TP(cB, cB2, t + 2);
            if constexpr (Epi::HAS_MID) { if (t == nth) { if constexpr (F8) asm volatile("s_nop 15" ::: "memory"); E.mid(acc, cur, wr, wc, fr, fq); } }
            const char* a3 = a2 + kstep; const char* b3 = b2 + kstep;
            if (last && has_next) S.a_ready(nxt);
            PG8_LDB(B0, 0, 0); PG8_SCHED; PG8_LDA(At, 0, 0); PG8_STAGE(PG8_SA(1, 1), a1 + hstep, voffA);
            PG8_WAIT_L(8); PG8_BAR; PG8_WAIT_L(0); PG8_MMA(0, 0, At, B0); PG8_BAR; PG8_SCHED;
            PG8_LDB(B1, 0, 1); PG8_STAGE(PG8_SB(0, 0), b2, voffB);
            PG8_BAR; PG8_WAIT_L(0); PG8_MMA(0, 1, At, B1); PG8_BAR;
            PG8_LDA(At, 0, 1); PG8_STAGE(PG8_SA(0, 0), a2, voffA);
            PG8_BAR; PG8_WAIT_L(0); PG8_MMA(1, 0, At, B0); PG8_BAR; PG8_SCHED;
            PG8_STAGE(PG8_SB(0, 1), b2 + hstep, voffB);
            PG8_WAIT_V(6); PG8_BAR; PG8_MMA(1, 1, At, B1); PG8_BAR;
            PG8_LDB(B0, 1, 0); PG8_SCHED; PG8_LDA(At, 1, 0); PG8_STAGE(PG8_SA(0, 1), a2 + hstep, voffA);
            PG8_WAIT_L(8); PG8_BAR; PG8_WAIT_L(0); PG8_MMA(0, 0, At, B0); PG8_BAR; PG8_SCHED;
            PG8_LDB(B1, 1, 1); PG8_STAGE(PG8_SB(1, 0), b3, voffB);
            PG8_BAR; PG8_WAIT_L(0); PG8_MMA(0, 1, At, B1); PG8_BAR;
            PG8_LDA(At, 1, 1); PG8_STAGE(PG8_SA(1, 0), a3, voffA);
            PG8_BAR; PG8_WAIT_L(0); PG8_MMA(1, 0, At, B0); PG8_BAR; PG8_SCHED;
            PG8_STAGE(PG8_SB(1, 1), b3 + hstep, voffB);
            PG8_WAIT_V(6); PG8_BAR; PG8_MMA(1, 1, At, B1); PG8_BAR;
        }
        PG8_STAMP();
        if constexpr (F8) asm volatile("s_nop 15" ::: "memory");
        if constexpr (!Epi::AFTER_DRAIN) { E(acc, cur, wr, wc, fr, fq); S.done(cur); }
        PG8_STAMP();
        if (!has_next) break;
#pragma unroll
        for (int a = 0; a < 2; ++a)
#pragma unroll
            for (int b = 0; b < 2; ++b)
#pragma unroll
                for (int m = 0; m < 4; ++m)
#pragma unroll
                    for (int n = 0; n < 2; ++n) acc[a][b][m][n] = (f32x4){0.f, 0.f, 0.f, 0.f};
        cur = nxt; cA = nA; cB = nB; ++ui;
        if constexpr (Epi::HAS_MID) { cA2 = (const char*)g.A2 + (size_t)cur.pm * tstep; cB2 = (const char*)g.Bt2 + (size_t)cur.pn * tstep; }
    }
    PG8_WAIT_V(0);
    if (wr == 0) PG8_BAR;
    PG8_BAR;
    if constexpr (Epi::AFTER_DRAIN) { E.fused(acc, cur, wr, wc, fr, fq, lds, wid, lane); S.done(cur); }
    PG8_STAMP();
    if (STAMP && wid == 0) { stamps[lane] = lane < nts ? (((unsigned long long)(unsigned)ts_hi << 32) | (unsigned)ts_lo) : 0ull;
        if (lane == 62) stamps[62] = rt_entry; if (lane == 63) stamps[63] = (unsigned long long)wall_clock64(); }
#undef PG8_STAMP
#undef PG8_TP
#undef PG8_SA
#undef PG8_SB
#undef PG8_STAGE
#undef PG8_LDA
#undef PG8_LDB
#undef PG8_MMA
#undef PG8_CAT8
#undef PG8_WAIT_V
#undef PG8_WAIT_L
#undef PG8_BAR
#undef PG8_SCHED
}
}

constexpr int T = 16384, D = 2048, SEQ = 4096, NB = 4;
constexpr int NIN = 15360, WIN_LD = 15376;
constexpr float EPS = 1e-6f;
constexpr int NWAVES = 8, NTHR = 512;
constexpr int NPHASE = 11;
constexpr size_t MiB = 1u << 20;
#ifndef IN16_COLS
#define IN16_COLS 0
#endif
constexpr size_t WS_CTL = 0, CTL_ZERO_BYTES = 64 * 1024;
constexpr size_t WS_GATES = 1 * MiB;
constexpr size_t WS_U = 2 * MiB, WS_MX = WS_U + 512 * 1024, WS_WI = WS_MX + 512 * 1024, WS_WK = WS_WI + 512 * 1024, WS_MR = WS_WK + 512 * 1024, WS_DEN = WS_MR + 512 * 1024, WS_DEC = WS_DEN + 512 * 1024;
constexpr size_t WS_B4G = 6 * MiB;
constexpr size_t WS_XN = 8 * MiB;
constexpr size_t WS_Q = 72 * MiB;
constexpr size_t WS_K = 136 * MiB;
constexpr size_t WS_AQ = 200 * MiB;
constexpr size_t WS_KT = 264 * MiB;
constexpr size_t WS_VT = 328 * MiB;
constexpr size_t WS_SO = 392 * MiB;
constexpr size_t WS_AK = 456 * MiB, WS_AV = 472 * MiB;
constexpr size_t WS_WIN16 = 488 * MiB;
constexpr size_t WS_WIN8 = (IN16_COLS == 0 ? 488 : 504) * MiB;
constexpr size_t WS_XN8 = 530 * MiB;
constexpr size_t WS_SS = 488 * MiB;
constexpr size_t WS_EXP = 488 * MiB, WS_GATE = 496 * MiB;
constexpr size_t WS_WA = 504 * MiB, WS_WM = 512 * MiB, WS_WO = 520 * MiB, WS_WQ = 528 * MiB;
constexpr size_t WS_KEYS = 536 * MiB;
constexpr size_t WS_AC = 540 * MiB, WS_NC = 544 * MiB;
constexpr size_t WS_END = 562 * MiB;
#ifndef P6_FP8
#define P6_FP8 1
#endif
constexpr int N16 = IN16_COLS;
constexpr float XN8_SCALE = 8.0f, WIN8_SCALE = 256.0f, H8_SCALE = 8.0f;
constexpr size_t WS_HA8 = WS_XN, WS_HM8 = WS_KT + 32 * MiB;
constexpr int CW_BAR = 4096;

constexpr int LDS_BYTES = 147456;
constexpr int MISC_OFF = 147456 - 256;

#define GAS __attribute__((address_space(1)))
#define LAS __attribute__((address_space(3)))
typedef unsigned short bf16_t;
typedef float f32x4 __attribute__((ext_vector_type(4)));
typedef float f32x16 __attribute__((ext_vector_type(16)));
typedef float f32x2v __attribute__((ext_vector_type(2)));
typedef short bf16x8 __attribute__((ext_vector_type(8)));
typedef short s16x4 __attribute__((ext_vector_type(4)));
typedef unsigned u32x4 __attribute__((ext_vector_type(4)));
typedef unsigned u32x2 __attribute__((ext_vector_type(2)));
typedef __bf16 bf2_t __attribute__((ext_vector_type(2)));

__device__ __forceinline__ unsigned f2bf(float f) { return (unsigned)__builtin_bit_cast(unsigned short, (__bf16)f); }
__device__ __forceinline__ unsigned cvtpk(float lo, float hi) { bf2_t v; v[0] = (__bf16)lo; v[1] = (__bf16)hi; return __builtin_bit_cast(unsigned, v); }
__device__ __forceinline__ unsigned pk2(float lo, float hi) { return cvtpk(lo, hi); }
__device__ __forceinline__ float bflo(unsigned u) { return __uint_as_float(u << 16); }
__device__ __forceinline__ float bfhi(unsigned u) { return __uint_as_float(u & 0xffff0000u); }
__device__ __forceinline__ float wave_sum(float v) {
#pragma unroll
    for (int o = 1; o < 64; o <<= 1) v += __shfl_xor(v, o);
    return v;
}
__device__ __forceinline__ float sigmoidf_(float x) { return __builtin_amdgcn_rcpf(1.0f + __expf(-x)); }
__device__ __forceinline__ bf16x8 pack8(const f32x4 a, const f32x4 b) {
    u32x4 w; w.x = cvtpk(a[0], a[1]); w.y = cvtpk(a[2], a[3]); w.z = cvtpk(b[0], b[1]); w.w = cvtpk(b[2], b[3]);
    return __builtin_bit_cast(bf16x8, w);
}
#define MFMA16(a, b, c) __builtin_amdgcn_mfma_f32_16x16x32_bf16((a), (b), (c), 0, 0, 0)
#define GLDS16(gptr, ldsptr) __builtin_amdgcn_global_load_lds((const unsigned*)(gptr), (LAS unsigned*)(ldsptr), 16, 0, 0)
#define GLDS4(gptr, ldsptr) __builtin_amdgcn_global_load_lds((const unsigned*)(gptr), (LAS unsigned*)(ldsptr), 4, 0, 0)
#define VM_WAIT() asm volatile("s_waitcnt vmcnt(0)" ::: "memory")

#define XB_TMO      128
#define XB_XCNT(j)  (256  + 64 * (j))
#define XB_XSUB(j)  (1280 + 64 * (j))
#define XB_XGEN(j)  (2304 + 64 * (j))
#define XB_TOP      3328
#define XB_TOPGEN   3392
#define XCD_BAR_WORDS 3456
#define XB_SPIN_CAP (1u << 18)

__device__ __forceinline__ unsigned xb_ld(unsigned* p)              { return __hip_atomic_load(p, __ATOMIC_RELAXED, __HIP_MEMORY_SCOPE_AGENT); }
__device__ __forceinline__ unsigned xb_add(unsigned* p, unsigned v) { return __hip_atomic_fetch_add(p, v, __ATOMIC_RELAXED, __HIP_MEMORY_SCOPE_AGENT); }
__device__ __forceinline__ unsigned xb_xcc_id() { return (unsigned)__builtin_amdgcn_s_getreg((3 << 11) | 20) & 0xFu; }
#define XB_SPIN(cond, bar) do { unsigned _sp = 0; while (cond) { __builtin_amdgcn_s_sleep(1); \
    if ((++_sp & 255u) == 0u) { if (xb_ld(&(bar)[XB_TMO])) break; if (_sp > XB_SPIN_CAP) { atomicAdd(&(bar)[XB_TMO], 1u); break; } } } } while (0)

struct XcdBarrier {
    unsigned* bar; unsigned x;
    volatile LAS unsigned* st;
};

__device__ __forceinline__ XcdBarrier xcd_barrier_post(unsigned* bar, volatile LAS unsigned* st) {
    XcdBarrier b; b.bar = bar; b.x = xb_xcc_id(); b.st = st;
    if (threadIdx.x == 0) (void)xb_add(&bar[XB_XCNT(b.x)], 1u);
    return b;
}
__device__ __forceinline__ void xcd_barrier_complete(unsigned* bar, unsigned x, unsigned& nloc, unsigned& nx) {
    const unsigned G = gridDim.x * gridDim.y * gridDim.z;
    unsigned sum, cnt, mine, sp = 0u;
    for (;;) {
        sum = 0u; cnt = 0u; mine = 0u;
#pragma unroll
        for (unsigned j = 0; j < 16; ++j) { const unsigned c = xb_ld(&bar[XB_XCNT(j)]); sum += c; cnt += (c > 0u) ? 1u : 0u; mine = (j == x) ? c : mine; }
        if (sum == G) break;
        __builtin_amdgcn_s_sleep(1);
        if ((++sp & 255u) == 0u) { if (xb_ld(&bar[XB_TMO])) break; if (sp > XB_SPIN_CAP) { atomicAdd(&bar[XB_TMO], 1u); break; } }
    }
    nloc = mine > 0u ? mine : 1u; nx = cnt > 0u ? cnt : 1u;
}

__device__ __forceinline__ void xcd_barrier(const XcdBarrier& b) {
    asm volatile("s_waitcnt vmcnt(0)" ::: "memory");
    __syncthreads();
    if (threadIdx.x == 0) {
        unsigned* bar = b.bar;
        __builtin_amdgcn_s_waitcnt(0);
        unsigned nloc = b.st[0], nx = b.st[1];
        if (nloc == 0u) { xcd_barrier_complete(bar, b.x, nloc, nx); b.st[0] = nloc; b.st[1] = nx; }
        const unsigned old = xb_add(&bar[XB_XSUB(b.x)], 1u);
        const unsigned gen = old / nloc;
        if (old + 1u == (gen + 1u) * nloc) {
            __builtin_amdgcn_fence(__ATOMIC_RELEASE, "agent");
            asm volatile("s_waitcnt vmcnt(0)" ::: "memory");
            const unsigned og = xb_add(&bar[XB_TOP], 1u);
            const unsigned tg = og / nx;
            if (og + 1u == (tg + 1u) * nx) xb_add(&bar[XB_TOPGEN], 1u);
            else XB_SPIN(xb_ld(&bar[XB_TOPGEN]) == tg, bar);
            __builtin_amdgcn_fence(__ATOMIC_ACQUIRE, "agent");
            xb_add(&bar[XB_XGEN(b.x)], 1u);
            asm volatile("s_waitcnt vmcnt(0)" ::: "memory");
        } else {
            XB_SPIN(xb_ld(&bar[XB_XGEN(b.x)]) == gen, bar);
            __builtin_amdgcn_fence(__ATOMIC_ACQUIRE, "agent");
            asm volatile("s_waitcnt vmcnt(0)" ::: "memory");
        }
    }
    __syncthreads();
}

struct EpiInProj {
    static constexpr bool PERM = true, AFTER_DRAIN = false, HAS_MID = false;
    unsigned char* ws; bf16_t* GM;
    template <int ACT>
    __device__ __forceinline__ void rows(const f32x4 (&acc)[2][2][4][2], bf16_t* dst, int ldc, int colt, float scale, int row0, int wc, int fq) const {
#pragma unroll
        for (int ai = 0; ai < 2; ++ai)
#pragma unroll
            for (int m = 0; m < 4; ++m) { bf16_t* rowp = dst + (size_t)(row0 + ai * 128 + m * 16) * ldc + colt + wc * 32 + 8 * fq;
#pragma unroll
                for (int bj = 0; bj < 2; ++bj) { f32x4 v0 = acc[ai][bj][m][0], v1 = acc[ai][bj][m][1];
                    if (ACT == 1) {
#pragma unroll
                        for (int j = 0; j < 4; ++j) { v0[j] = sigmoidf_(v0[j] * scale); v1[j] = sigmoidf_(v1[j] * scale); } }
                    else { v0 = v0 * scale; v1 = v1 * scale; }
                    u32x4 w; w.x = cvtpk(v0[0], v0[1]); w.y = cvtpk(v0[2], v0[3]); w.z = cvtpk(v1[0], v1[1]); w.w = cvtpk(v1[2], v1[3]);
                    *(u32x4*)(rowp + bj * 128) = w; } }
    }
    __device__ __forceinline__ void rowsTiled(const f32x4 (&acc)[2][2][4][2], bf16_t* dst, int pm, int pnl, float scale, int row0, int wc, int fq) const {
        const int fr = row0 & 15, wr = (row0 >> 6) & 1;
        unsigned char* base = (unsigned char*)dst + ((size_t)((pm * 8 + pnl) * 8 + wr * 4 + wc)) * 16384 + (fq * 16 + fr) * 16;
#pragma unroll
        for (int ai = 0; ai < 2; ++ai)
#pragma unroll
            for (int bj = 0; bj < 2; ++bj)
#pragma unroll
                for (int m = 0; m < 4; ++m) { f32x4 v0 = acc[ai][bj][m][0], v1 = acc[ai][bj][m][1];
#pragma unroll
                    for (int j = 0; j < 4; ++j) { v0[j] = sigmoidf_(v0[j] * scale); v1[j] = sigmoidf_(v1[j] * scale); }
                    u32x4 w; w.x = cvtpk(v0[0], v0[1]); w.y = cvtpk(v0[2], v0[3]); w.z = cvtpk(v1[0], v1[1]); w.w = cvtpk(v1[2], v1[3]);
                    *(u32x4*)(base + ((ai * 2 + bj) * 4 + m) * 1024) = w; }
    }
    __device__ __forceinline__ void rowsT(const f32x4 (&acc)[2][2][4][2], bf16_t* dst, int colt, float scale, int row0, int wc, int fq) const {
        const int head = colt >> 9, d0 = (colt & 511) + wc * 32 + 8 * fq;
#pragma unroll
        for (int ai = 0; ai < 2; ++ai)
#pragma unroll
            for (int m = 0; m < 4; ++m) { const int r = row0 + ai * 128 + m * 16, b = r >> 12, s = r & 4095, chunk = s >> 6, j = s & 63;
                bf16_t* base = dst + ((size_t)((b * 4 + head) * 64 + chunk) * 512) * 64 + j;
#pragma unroll
                for (int bj = 0; bj < 2; ++bj)
#pragma unroll
                    for (int n = 0; n < 2; ++n)
#pragma unroll
                        for (int e = 0; e < 4; ++e) base[(size_t)(d0 + bj * 128 + 4 * n + e) * 64] = (bf16_t)f2bf(acc[ai][bj][m][n][e] * scale); }
    }
    int pn0; float osc;
    __device__ __forceinline__ void operator()(const f32x4 (&acc)[2][2][4][2], const pg8::Unit& u, int wr, int wc, int fr, int fq) const {
        const int pn = u.pn + pn0; int row0 = u.pm * 256 + wr * 64 + fr;
        asm volatile("" : "+v"(row0), "+v"(fq));
        bf16_t *Q = (bf16_t*)(ws + WS_Q), *K = (bf16_t*)(ws + WS_K), *KT = (bf16_t*)(ws + WS_KT), *VT = (bf16_t*)(ws + WS_VT), *SO = (bf16_t*)(ws + WS_SO), *AQ = (bf16_t*)(ws + WS_AQ), *AK = (bf16_t*)(ws + WS_AK), *AV = (bf16_t*)(ws + WS_AV);
        bf16_t* GA = GM + (size_t)T * D;
        if (pn < 8) rows<0>(acc, Q, D, pn * 256, osc, row0, wc, fq);
        else if (pn < 16) { rows<0>(acc, K, D, (pn - 8) * 256, 0.04419417382415922f * osc, row0, wc, fq); rowsT(acc, KT, (pn - 8) * 256, 0.04419417382415922f * osc, row0, wc, fq); }
        else if (pn < 24) rowsT(acc, VT, (pn - 16) * 256, osc, row0, wc, fq);
        else if (pn < 32) rows<1>(acc, SO, D, (pn - 24) * 256, osc, row0, wc, fq);
        else if (pn < 40) rows<0>(acc, AQ, D, (pn - 32) * 256, osc, row0, wc, fq);
        else if (pn < 42) rows<0>(acc, AK, 512, (pn - 40) * 256, osc, row0, wc, fq);
        else if (pn < 44) rows<0>(acc, AV, 512, (pn - 42) * 256, osc, row0, wc, fq);
        else if (pn < 52) rowsTiled(acc, GM, u.pm, pn - 44, osc, row0, wc, fq);
        else rowsTiled(acc, GA, u.pm, pn - 52, osc, row0, wc, fq);
    }
};
struct EpiMerge2 {
    static constexpr bool PERM = true, AFTER_DRAIN = false, HAS_MID = true;
    const bf16_t *GA, *GM; bf16_t* OUT; float osc;
    __device__ __forceinline__ void mid(f32x4 (&acc)[2][2][4][2], const pg8::Unit& u, int wr, int wc, int fr, int fq) const {
        int row0 = u.pm * 256 + wr * 64 + fr, col0 = u.pn * 256 + wc * 32 + 8 * fq;
        asm volatile("" : "+v"(row0), "+v"(col0));
        size_t tb0 = ((size_t)((u.pm * 8 + u.pn) * 8 + wr * 4 + wc)) * 16384 + (size_t)(fq * 16 + fr) * 16;
        asm volatile("" : "+v"(tb0));
        u32x4 ga[2][2], gm[2][2];
#define EM2_LOAD(g) do { const size_t toff = tb0 + (size_t)((((g) >> 2) * 2) * 4 + ((g) & 3)) * 1024;   \
            _Pragma("unroll") for (int bj = 0; bj < 2; ++bj) { ga[(g) & 1][bj] = *(const u32x4*)((const unsigned char*)GA + toff + bj * 4096); gm[(g) & 1][bj] = *(const u32x4*)((const unsigned char*)GM + toff + bj * 4096); } } while (0)
        EM2_LOAD(0);
#pragma unroll
        for (int g = 0; g < 8; ++g) { const int ai = g >> 2, m = g & 3;
            if (g + 1 < 8) EM2_LOAD(g + 1);
#pragma unroll
            for (int bj = 0; bj < 2; ++bj) { const u32x4 a = ga[g & 1][bj], q = gm[g & 1][bj];
                f32x4 r0, r1;
                r0[0] = bflo(a.x) * __builtin_amdgcn_rcpf(fmaxf(bflo(q.x), 1e-20f)); r0[1] = bfhi(a.x) * __builtin_amdgcn_rcpf(fmaxf(bfhi(q.x), 1e-20f));
                r0[2] = bflo(a.y) * __builtin_amdgcn_rcpf(fmaxf(bflo(q.y), 1e-20f)); r0[3] = bfhi(a.y) * __builtin_amdgcn_rcpf(fmaxf(bfhi(q.y), 1e-20f));
                r1[0] = bflo(a.z) * __builtin_amdgcn_rcpf(fmaxf(bflo(q.z), 1e-20f)); r1[1] = bfhi(a.z) * __builtin_amdgcn_rcpf(fmaxf(bfhi(q.z), 1e-20f));
                r1[2] = bflo(a.w) * __builtin_amdgcn_rcpf(fmaxf(bflo(q.w), 1e-20f)); r1[3] = bfhi(a.w) * __builtin_amdgcn_rcpf(fmaxf(bfhi(q.w), 1e-20f));
                acc[ai][bj][m][0] = acc[ai][bj][m][0] * r0; acc[ai][bj][m][1] = acc[ai][bj][m][1] * r1; }
            asm volatile("" ::: "memory"); }
#undef EM2_LOAD
    }
    __device__ __forceinline__ void operator()(const f32x4 (&acc)[2][2][4][2], const pg8::Unit& u, int wr, int wc, int fr, int fq) const {
        int row0 = u.pm * 256 + wr * 64 + fr, col0 = u.pn * 256 + wc * 32 + 8 * fq;
        size_t tb0 = ((size_t)((u.pm * 8 + u.pn) * 8 + wr * 4 + wc)) * 16384 + (size_t)(fq * 16 + fr) * 16;
        asm volatile("" : "+v"(row0), "+v"(col0), "+v"(tb0));
#pragma unroll
        for (int ai = 0; ai < 2; ++ai)
#pragma unroll
            for (int m = 0; m < 4; ++m) { const size_t off = (size_t)(row0 + ai * 128 + m * 16) * D + col0;
#pragma unroll
                for (int bj = 0; bj < 2; ++bj) { const u32x4 g = *(const u32x4*)((const unsigned char*)GM + tb0 + (size_t)((ai * 2 + bj) * 4 + m) * 1024);
                    f32x4 o0, o1; o0[0] = bflo(g.x); o0[1] = bfhi(g.x); o0[2] = bflo(g.y); o0[3] = bfhi(g.y); o1[0] = bflo(g.z); o1[1] = bfhi(g.z); o1[2] = bflo(g.w); o1[3] = bfhi(g.w);
                    o0 = o0 * acc[ai][bj][m][0] * osc; o1 = o1 * acc[ai][bj][m][1] * osc;
#if P6_FP8
                    int p0 = 0, p1 = 0;
                    p0 = __builtin_amdgcn_cvt_pk_fp8_f32(o0[0], o0[1], p0, false); p0 = __builtin_amdgcn_cvt_pk_fp8_f32(o0[2], o0[3], p0, true);
                    p1 = __builtin_amdgcn_cvt_pk_fp8_f32(o1[0], o1[1], p1, false); p1 = __builtin_amdgcn_cvt_pk_fp8_f32(o1[2], o1[3], p1, true);
                    u32x2 w; w.x = (unsigned)p0; w.y = (unsigned)p1;
                    *(u32x2*)((unsigned char*)OUT + off + bj * 128) = w; } }
#else
                    u32x4 w; w.x = cvtpk(o0[0], o0[1]); w.y = cvtpk(o0[2], o0[3]); w.z = cvtpk(o1[0], o1[1]); w.w = cvtpk(o1[2], o1[3]);
                    *(u32x4*)(OUT + off + bj * 128) = w; } }
#endif
    }
};
struct EpiResid {
    static constexpr bool PERM = false, AFTER_DRAIN = false, HAS_MID = false;
    const float* BASE; float* OUT; float osc;
    __device__ __forceinline__ void operator()(const f32x4 (&acc)[2][2][4][2], const pg8::Unit& u, int wr, int wc, int fr, int fq) const {
        const int row0 = u.pm * 256 + wr * 64 + fr, col0 = u.pn * 256 + wc * 32 + 4 * fq;
#pragma unroll
        for (int ai = 0; ai < 2; ++ai)
#pragma unroll
            for (int m = 0; m < 4; ++m) { const size_t off = (size_t)(row0 + ai * 128 + m * 16) * D + col0;
#pragma unroll
                for (int bj = 0; bj < 2; ++bj)
#pragma unroll
                    for (int n = 0; n < 2; ++n) *(f32x4*)(OUT + off + bj * 128 + n * 16) = *(const f32x4*)(BASE + off + bj * 128 + n * 16) + acc[ai][bj][m][n] * osc; }
    }
};
struct EpiPlainBf16 {
    static constexpr bool PERM = true, AFTER_DRAIN = false, HAS_MID = false;
    bf16_t* OUT;
    __device__ __forceinline__ void operator()(const f32x4 (&acc)[2][2][4][2], const pg8::Unit& u, int wr, int wc, int fr, int fq) const {
        const int row0 = u.pm * 256 + wr * 64 + fr, col0 = u.pn * 256 + wc * 32 + 8 * fq;
#pragma unroll
        for (int ai = 0; ai < 2; ++ai)
#pragma unroll
            for (int m = 0; m < 4; ++m) { const int t = row0 + ai * 128 + m * 16;
#pragma unroll
                for (int bj = 0; bj < 2; ++bj) { const f32x4 v0 = acc[ai][bj][m][0], v1 = acc[ai][bj][m][1];
                    u32x4 w; w.x = cvtpk(v0[0], v0[1]); w.y = cvtpk(v0[2], v0[3]); w.z = cvtpk(v1[0], v1[1]); w.w = cvtpk(v1[2], v1[3]);
                    const int c = col0 + bj * 128;
                    *(u32x4*)((unsigned char*)OUT + ((size_t)((((t >> 5) * 8 + (c >> 8)) * 2 + ((c >> 7) & 1)) * 8 + ((c >> 4) & 7))) * 1024 + (((c >> 3) & 1) * 32 + (t & 31)) * 16) = w; } }
    }
};

struct Args {
    const float *x, *norm1_g, *w_in, *gate_b, *mnorm_g, *w_m, *gq, *gk, *sink, *rel_bias, *w_a, *w_out, *norm2_g, *peer_wq, *peer_keys, *peer_u, *peer_v;
    float* out; unsigned char* ws; int ph_lo, ph_hi;
};

__device__ __forceinline__ void transpose_item(const float* W, int ldw, int K, int nblk, bf16_t* WT, LAS float* scr, int item, int lane, bool skip16) {
    const int kb = item / nblk, nb = item % nblk, k0 = 64 * kb, n0 = 32 * nb, ns = n0 + ((skip16 && n0 >= 8192) ? 16 : 0);
#pragma unroll
    for (int i = 0; i < 32; ++i) { const int kk = 2 * i + (lane >> 5); scr[kk * 33 + (lane & 31)] = W[(size_t)(k0 + kk) * ldw + ns + (lane & 31)]; }
    asm volatile("s_waitcnt lgkmcnt(0)" ::: "memory");
    const int c = lane & 7;
#pragma unroll
    for (int j = 0; j < 4; ++j) { const int n = (lane >> 3) + 8 * j; const LAS float* s = scr + (8 * c) * 33 + n;
        u32x4 o; o.x = pk2(s[0 * 33], s[1 * 33]); o.y = pk2(s[2 * 33], s[3 * 33]); o.z = pk2(s[4 * 33], s[5 * 33]); o.w = pk2(s[6 * 33], s[7 * 33]);
        *(u32x4*)(WT + (size_t)(n0 + n) * K + k0 + 8 * c) = o; }
    asm volatile("s_waitcnt lgkmcnt(0)" ::: "memory");
}
template <bool INPROJ> __device__ __forceinline__ void transpose_item8(const float* W, int ldw, int K, int nblk, unsigned char* WT8, LAS float* scr, int item, int lane) {
    const int kb = item / nblk, nb = item % nblk, k0 = 64 * kb, n0 = 32 * nb, ns = n0 + ((INPROJ && n0 >= 8192) ? 16 : 0), nd = INPROJ ? n0 - N16 : n0;
#pragma unroll
    for (int i = 0; i < 32; ++i) { const int kk = 2 * i + (lane >> 5); scr[kk * 33 + (lane & 31)] = W[(size_t)(k0 + kk) * ldw + ns + (lane & 31)]; }
    asm volatile("s_waitcnt lgkmcnt(0)" ::: "memory");
    const int c = lane & 7;
#pragma unroll
    for (int j = 0; j < 4; ++j) { const int n = (lane >> 3) + 8 * j; const LAS float* s = scr + (8 * c) * 33 + n;
        int p0 = 0, p1 = 0;
        p0 = __builtin_amdgcn_cvt_pk_fp8_f32(s[0 * 33] * WIN8_SCALE, s[1 * 33] * WIN8_SCALE, p0, false); p0 = __builtin_amdgcn_cvt_pk_fp8_f32(s[2 * 33] * WIN8_SCALE, s[3 * 33] * WIN8_SCALE, p0, true);
        p1 = __builtin_amdgcn_cvt_pk_fp8_f32(s[4 * 33] * WIN8_SCALE, s[5 * 33] * WIN8_SCALE, p1, false); p1 = __builtin_amdgcn_cvt_pk_fp8_f32(s[6 * 33] * WIN8_SCALE, s[7 * 33] * WIN8_SCALE, p1, true);
        u32x2 o; o.x = (unsigned)p0; o.y = (unsigned)p1;
        *(u32x2*)(WT8 + (size_t)(nd + n) * K + k0 + 8 * c) = o; }
    asm volatile("s_waitcnt lgkmcnt(0)" ::: "memory");
}
__device__ __forceinline__ void convert_stream(const float* src, bf16_t* dst, size_t n, int gthread, int nthreads) {
    for (size_t i = (size_t)gthread * 8; i < n; i += (size_t)nthreads * 8) {
        const f32x4 a = *(const f32x4*)(src + i), b = *(const f32x4*)(src + i + 4);
        u32x4 w; w.x = pk2(a[0], a[1]); w.y = pk2(a[2], a[3]); w.z = pk2(b[0], b[1]); w.w = pk2(b[2], b[3]);
        *(u32x4*)(dst + i) = w; }
}

__device__ __forceinline__ void p0_prologue(const Args& A, LAS unsigned char* lds, int tid, int lane, int wave, int G) {
    unsigned char* ws = A.ws;
    bf16_t* XN = (bf16_t*)(ws + WS_XN); float* GATES = (float*)(ws + WS_GATES); bf16_t* WIN16 = (bf16_t*)(ws + WS_WIN16); unsigned char* WIN8 = ws + WS_WIN8; unsigned char* XN8 = ws + WS_XN8;
    LAS float* wg = (LAS float*)lds;
    for (int idx = tid; idx < 32768; idx += NTHR) { const int k = idx >> 4, g = idx & 15; wg[g * 2048 + k] = A.w_in[(size_t)k * WIN_LD + 8192 + g]; }
    __syncthreads();
    const int gw = blockIdx.x * NWAVES + wave, NGW = G * NWAVES;
    f32x4 gvr[8], xv[8];
#pragma unroll
    for (int j = 0; j < 8; ++j) { gvr[j] = *(const f32x4*)(A.norm1_g + 4 * lane + 256 * j); if (gw < T) xv[j] = *(const f32x4*)(A.x + (size_t)gw * D + 4 * lane + 256 * j); }
    for (int row = gw; row < T; row += NGW) {
        float ss = 0.f;
#pragma unroll
        for (int j = 0; j < 8; ++j) { const f32x4 v = xv[j]; ss += (v[0] * v[0] + v[1] * v[1]) + (v[2] * v[2] + v[3] * v[3]); }
        const float rstd = 1.0f / sqrtf(wave_sum(ss) * (1.0f / D) + EPS);
        f32x4 xn[8];
        if (row + NGW < T) {
#pragma unroll
            for (int j = 0; j < 8; ++j) xn[j] = *(const f32x4*)(A.x + (size_t)(row + NGW) * D + 4 * lane + 256 * j); }
        float acc[16];
#pragma unroll
        for (int g = 0; g < 16; ++g) acc[g] = 0.f;
#pragma unroll
        for (int j = 0; j < 8; ++j) { const f32x4 v = xv[j] * rstd * gvr[j];
            u32x2 w; w.x = pk2(v[0], v[1]); w.y = pk2(v[2], v[3]);
            if (N16 > 0) *(u32x2*)(XN + (size_t)row * D + 4 * lane + 256 * j) = w;
            { int p8 = 0; p8 = __builtin_amdgcn_cvt_pk_fp8_f32(v[0] * XN8_SCALE, v[1] * XN8_SCALE, p8, false); p8 = __builtin_amdgcn_cvt_pk_fp8_f32(v[2] * XN8_SCALE, v[3] * XN8_SCALE, p8, true); *(int*)(XN8 + (size_t)row * D + 4 * lane + 256 * j) = p8; }
            const LAS float* wgj = wg + 4 * lane + 256 * j;
#pragma unroll
            for (int g = 0; g < 16; ++g) { const f32x4 w4 = *(const LAS f32x4*)(wgj + g * 2048); acc[g] += (v[0] * w4[0] + v[1] * w4[1]) + (v[2] * w4[2] + v[3] * w4[3]); }
            __builtin_amdgcn_sched_barrier(0); }
#pragma unroll
        for (int j = 0; j < 8; ++j) xv[j] = xn[j];
#pragma unroll
        for (int i = 0; i < 8; ++i) { const float send = (lane & 1) ? acc[i] : acc[i + 8], keep = (lane & 1) ? acc[i + 8] : acc[i]; acc[i] = keep + __shfl_xor(send, 1); }
#pragma unroll
        for (int i = 0; i < 4; ++i) { const float send = (lane & 2) ? acc[i] : acc[i + 4], keep = (lane & 2) ? acc[i + 4] : acc[i]; acc[i] = keep + __shfl_xor(send, 2); }
#pragma unroll
        for (int i = 0; i < 2; ++i) { const float send = (lane & 4) ? acc[i] : acc[i + 2], keep = (lane & 4) ? acc[i + 2] : acc[i]; acc[i] = keep + __shfl_xor(send, 4); }
        { const float send = (lane & 8) ? acc[0] : acc[1], keep = (lane & 8) ? acc[1] : acc[0]; acc[0] = keep + __shfl_xor(send, 8); }
        float tot = acc[0]; tot += __shfl_xor(tot, 16); tot += __shfl_xor(tot, 32);
        const int gidx = ((lane & 1) << 3) | ((lane & 2) << 1) | ((lane & 4) >> 1) | ((lane & 8) >> 3);
        if (lane < 16) GATES[(size_t)row * 16 + gidx] = tot;
    }
    __syncthreads();
    for (int i = blockIdx.x * NTHR + tid; i < 16 * 384; i += G * NTHR) { const int head = i / 384, i0 = i % 384 - 32; f32x4 v4;
#pragma unroll
        for (int e = 0; e < 4; ++e) { const int idx = i0 + e, rel = idx - 128, n = rel < 0 ? -rel : rel;
            const int bk = (n < 8 ? n : n < 12 ? 8 : n < 16 ? 9 : n < 23 ? 10 : n < 32 ? 11 : n < 46 ? 12 : n < 64 ? 13 : n < 91 ? 14 : 15) + (rel > 0 ? 16 : 0);
            v4[e] = (idx >= 0 && idx <= 256) ? A.rel_bias[bk * 16 + head] * 1.4426950408889634f : 0.f; }
        *(f32x4*)(ws + WS_B4G + (size_t)i * 16) = v4; }
    LAS float* scr = (LAS float*)(lds + wave * 8704);
    constexpr int NBLK = NIN / 32, NITEMS = (D / 64) * NBLK;
    for (int it = gw; it < NITEMS; it += NGW) { if (it % NBLK < N16 / 32) transpose_item(A.w_in, WIN_LD, D, NBLK, WIN16, scr, it, lane, true); else transpose_item8<true>(A.w_in, WIN_LD, D, NBLK, WIN8, scr, it, lane); }
}

__device__ __forceinline__ float logsigmoidf_(float x) { return fminf(x, 0.f) - log1pf(__expf(-fabsf(x))); }
__device__ __forceinline__ void gate_scan(const Args& A, LAS unsigned char* lds, int chain, int tid, int lane, int wave) {
    unsigned char* ws = A.ws;
    const float* GATES = (const float*)(ws + WS_GATES);
    float *U = (float*)(ws + WS_U), *MX = (float*)(ws + WS_MX), *WI = (float*)(ws + WS_WI), *WK = (float*)(ws + WS_WK), *MR = (float*)(ws + WS_MR), *DEC = (float*)(ws + WS_DEC);
    LAS float* BL = (LAS float*)lds; LAS float* PA = BL + 64; LAS float* MC = BL + 128; LAS float* MN = BL + 192;
    const int dir = chain & 1, bh = chain >> 1, b = bh >> 2, h = bh & 3;
    const float bi = A.gate_b[(dir * 2 + 0) * 4 + h], bf = A.gate_b[(dir * 2 + 1) * 4 + h];
    float bc[8], uu[8], pm[8];
#pragma unroll
    for (int i = 0; i < 8; ++i) { const int c = wave * 8 + i; const size_t t = (size_t)b * SEQ + 64 * c + lane;
        const float gi = GATES[t * 16 + dir * 8 + h] + bi, gf = GATES[t * 16 + dir * 8 + 4 + h] + bf;
        float s = logsigmoidf_(gf);
        if (!dir) {
#pragma unroll
            for (int o = 1; o < 64; o <<= 1) { const float t2 = __shfl_up(s, o); if (lane >= o) s += t2; }
        } else {
#pragma unroll
            for (int o = 1; o < 64; o <<= 1) { const float t2 = __shfl_down(s, o); if (lane + o < 64) s += t2; }
        }
        float u = gi - s, p = u;
        if (!dir) {
#pragma unroll
            for (int o = 1; o < 64; o <<= 1) { const float t2 = __shfl_up(p, o); if (lane >= o) p = fmaxf(p, t2); }
        } else {
#pragma unroll
            for (int o = 1; o < 64; o <<= 1) { const float t2 = __shfl_down(p, o); if (lane + o < 64) p = fmaxf(p, t2); }
        }
        bc[i] = s; uu[i] = u; pm[i] = p;
        const float blast = __shfl(s, dir ? 0 : 63), pall = __shfl(p, dir ? 0 : 63);
        if (lane == 0) { BL[c] = blast; PA[c] = pall; }
    }
    __syncthreads();
    if (tid == 0) { float m = 0.f; for (int ci = 0; ci < 64; ++ci) { const int c = dir ? 63 - ci : ci; MC[c] = m; m = BL[c] + fmaxf(m, PA[c]); MN[c] = m; } }
    __syncthreads();
#pragma unroll
    for (int i = 0; i < 8; ++i) { const int c = wave * 8 + i; const size_t o = (size_t)chain * SEQ + 64 * c + lane;
        const float m = MC[c], mn = MN[c], bl = BL[c], mx = fmaxf(m, pm[i]);
        U[o] = uu[i]; MX[o] = mx; WI[o] = __expf(m - mx); MR[o] = bc[i] + mx; WK[o] = __expf(bl + uu[i] - mn);
        if (lane == 0) DEC[chain * 64 + c] = __expf(bl + m - mn); }
    __syncthreads();
}

__device__ __forceinline__ unsigned offb(unsigned row, unsigned ch) { return 256u * row + 16u * (ch ^ (((row & 3u) << 2) | ((row >> 2) & 3u))); }
__device__ __forceinline__ int t5_bucket_abs(int n) { return n < 8 ? n : n < 12 ? 8 : n < 16 ? 9 : n < 23 ? 10 : n < 32 ? 11 : n < 46 ? 12 : n < 64 ? 13 : n < 91 ? 14 : 15; }
constexpr int AT_BUF = 65536, AT_RSTD = 131072, AT_BIAS = AT_RSTD + 1024, AT_B4B = 6144, AT_GQK = AT_BIAS + 2 * AT_B4B;

__device__ __forceinline__ void attn_chunk_load(const bf16_t* AK, const bf16_t* AV, LAS unsigned char* buf, int b, int qb, int kvh, int ck, int wave, int lane) {
#pragma unroll
    for (int ii = 0; ii < 4; ++ii) { const int i = wave * 4 + ii, row = 4 * i + (lane >> 4), cpos = lane & 15;
        const int ch = cpos ^ (((row & 3) << 2) | ((row >> 2) & 3));
        int kp = 128 * (qb - 1) + 128 * ck + row; kp = kp < 0 ? 0 : (kp > SEQ - 1 ? SEQ - 1 : kp);
        const size_t so = (size_t)(b * SEQ + kp) * 512 + kvh * 128 + 8 * ch;
        GLDS16(AK + so, buf + i * 1024); GLDS16(AV + so, buf + 32768 + i * 1024); }
}
static_assert(AT_GQK + 512 <= MISC_OFF, "LDS map");
__device__ __forceinline__ void attn_phase(const Args& A, LAS unsigned char* lds, int vcu, int G, int tid, int lane, int wave) {
    unsigned char* ws = A.ws;
    const bf16_t *AQ = (const bf16_t*)(ws + WS_AQ), *AK = (const bf16_t*)(ws + WS_AK), *AV = (const bf16_t*)(ws + WS_AV); unsigned char* HA8 = ws + WS_HA8;
    const unsigned char* B4G = ws + WS_B4G;
    const int g = lane >> 4, ql = lane & 15, T0 = wave >> 1;
    LAS float* RSTD = (LAS float*)(lds + AT_RSTD); LAS float* GQK = (LAS float*)(lds + AT_GQK);
    if (tid < 128) GQK[tid] = A.gq[tid] * A.gk[tid] * 0.08838834764831845f;
    int gc = 0, ui = 0;
    u32x4 qraw[4];
    if (vcu < 2048) { const int head = vcu & 15, qb = (vcu >> 4) & 31, b = vcu >> 9;
        attn_chunk_load(AK, AV, lds, b, qb, head >> 2, 0, wave, lane);
        if (wave < 6) GLDS16(B4G + (size_t)head * 6144 + wave * 1024 + lane * 16, lds + AT_BIAS + wave * 1024);
#pragma unroll
        for (int s4 = 0; s4 < 4; ++s4) qraw[s4] = *(const u32x4*)(AQ + ((size_t)b * SEQ + 128 * qb + 16 * wave + ql) * D + head * 128 + 32 * s4 + 8 * g); }
    for (int unit = vcu; unit < 2048; unit += G, ++ui) {
        const int head = unit & 15, kvh = head >> 2, qb = (unit >> 4) & 31, b = unit >> 9;
        const size_t trow = (size_t)b * SEQ + 128 * qb + 16 * wave + ql;
        const LAS f32x4* B4 = (const LAS f32x4*)(lds + AT_BIAS + (ui & 1) * AT_B4B);
        f32x4 o[8]; float mrun = A.sink[head] * 1.4426950408889634f, lrun = 1.0f;
#pragma unroll
        for (int n = 0; n < 8; ++n) o[n] = (f32x4){0.f, 0.f, 0.f, 0.f};
        VM_WAIT(); __syncthreads();
        bf16x8 qf[4];
        { float ss = 0.f;
#pragma unroll
            for (int s4 = 0; s4 < 4; ++s4)
#pragma unroll
                for (int j = 0; j < 4; ++j) { const float lo = bflo(qraw[s4][j]), hi = bfhi(qraw[s4][j]); ss += lo * lo + hi * hi; }
            ss += __shfl_xor(ss, 16); ss += __shfl_xor(ss, 32);
            const float rq = 1.0f / sqrtf(ss * (1.0f / 128.0f) + EPS);
#pragma unroll
            for (int s4 = 0; s4 < 4; ++s4) { const f32x4 g0 = *(const LAS f32x4*)(GQK + 32 * s4 + 8 * g), g1 = *(const LAS f32x4*)(GQK + 32 * s4 + 8 * g + 4);
                u32x4 w;
                w.x = cvtpk(bflo(qraw[s4].x) * rq * g0[0], bfhi(qraw[s4].x) * rq * g0[1]); w.y = cvtpk(bflo(qraw[s4].y) * rq * g0[2], bfhi(qraw[s4].y) * rq * g0[3]);
                w.z = cvtpk(bflo(qraw[s4].z) * rq * g1[0], bfhi(qraw[s4].z) * rq * g1[1]); w.w = cvtpk(bflo(qraw[s4].w) * rq * g1[2], bfhi(qraw[s4].w) * rq * g1[3]);
                qf[s4] = __builtin_bit_cast(bf16x8, w); } }
#pragma unroll
        for (int ck = 0; ck < 3; ++ck, ++gc) {
            LAS unsigned char* kb_ = lds + (gc & 1) * AT_BUF; LAS unsigned char* vb_ = kb_ + 32768; LAS float* rs = RSTD + (gc & 1) * 128;
            if (ck < 2) attn_chunk_load(AK, AV, lds + ((gc + 1) & 1) * AT_BUF, b, qb, kvh, ck + 1, wave, lane);
            else if (unit + G < 2048) { const int nu = unit + G, nh = nu & 15, nqb = (nu >> 4) & 31, nb = nu >> 9;
                attn_chunk_load(AK, AV, lds + ((gc + 1) & 1) * AT_BUF, nb, nqb, nh >> 2, 0, wave, lane);
                if (wave < 6) GLDS16(B4G + (size_t)nh * 6144 + wave * 1024 + lane * 16, lds + AT_BIAS + ((ui + 1) & 1) * AT_B4B + wave * 1024);
#pragma unroll
                for (int s4 = 0; s4 < 4; ++s4) qraw[s4] = *(const u32x4*)(AQ + ((size_t)nb * SEQ + 128 * nqb + 16 * wave + ql) * D + nh * 128 + 32 * s4 + 8 * g); }
            { const int row = 16 * wave + (lane >> 2), qtr = lane & 3; float s2 = 0.f;
#pragma unroll
                for (int i = 0; i < 4; ++i) { const u32x4 kk = *(const LAS u32x4*)(kb_ + offb(row, 4 * qtr + i));
#pragma unroll
                    for (int j = 0; j < 4; ++j) { const float lo = bflo(kk[j]), hi = bfhi(kk[j]); s2 += lo * lo + hi * hi; } }
                s2 += __shfl_xor(s2, 1); s2 += __shfl_xor(s2, 2);
                if (qtr == 0) rs[row] = 1.4426950408889634f / sqrtf(s2 * (1.0f / 128.0f) + EPS); }
            __syncthreads();
            const int jlo = (ck == 0) ? (qb == 0 ? 4 : T0) : 0, jhi = (ck == 2) ? (qb == 31 ? -1 : T0) : 3;
            const unsigned rlo = 8 * (ql >> 2) + (ql & 3);
            f32x4 sc[8]; float mx = mrun;
            const int relb = 128 * ck + 8 * g - 128 - 16 * wave - ql;
            const LAS f32x4* b4_l = B4 + (relb + 128 + 32);
#pragma unroll
            for (int j = 0; j < 4; ++j) {
                if (j >= jlo && j <= jhi) {
                    bf16x8 kf[2][4]; f32x4 rk[2], bb[2];
#pragma unroll
                    for (int hf = 0; hf < 2; ++hf) {
#pragma unroll
                        for (int s4 = 0; s4 < 4; ++s4) kf[hf][s4] = *(const LAS bf16x8*)(kb_ + offb(rlo + 4 * hf, 4 * s4 + g) + 8192 * j);
                        rk[hf] = *(const LAS f32x4*)(rs + 8 * g + 32 * j + 4 * hf); bb[hf] = b4_l[32 * j + 4 * hf]; }
#pragma unroll
                    for (int hf = 0; hf < 2; ++hf) { f32x4 a = (f32x4){0.f, 0.f, 0.f, 0.f};
#pragma unroll
                        for (int s4 = 0; s4 < 4; ++s4) a = MFMA16(kf[hf][s4], qf[s4], a);
                        const int c0 = 32 * j + 4 * hf;
                        if (ck == 1) {
#pragma unroll
                            for (int e = 0; e < 4; ++e) { const float v = a[e] * rk[hf][e] + bb[hf][e]; a[e] = v; mx = fmaxf(mx, v); }
                        } else if (ck == 0) {
#pragma unroll
                            for (int e = 0; e < 4; ++e) { const float v = (relb + (c0 + e) >= -128) ? a[e] * rk[hf][e] + bb[hf][e] : -1e30f; a[e] = v; mx = fmaxf(mx, v); }
                        } else {
#pragma unroll
                            for (int e = 0; e < 4; ++e) { const float v = (relb + (c0 + e) <= 128) ? a[e] * rk[hf][e] + bb[hf][e] : -1e30f; a[e] = v; mx = fmaxf(mx, v); }
                        }
                        sc[2 * j + hf] = a; }
                } else { sc[2 * j] = (f32x4){-1e30f, -1e30f, -1e30f, -1e30f}; sc[2 * j + 1] = sc[2 * j]; }
            }
            mx = fmaxf(mx, __shfl_xor(mx, 16)); mx = fmaxf(mx, __shfl_xor(mx, 32));
            const float alpha = __builtin_amdgcn_exp2f(mrun - mx); mrun = mx;
            float l = 0.f;
#pragma unroll
            for (int t = 0; t < 8; ++t)
#pragma unroll
                for (int e = 0; e < 4; ++e) { const float p = __builtin_amdgcn_exp2f(sc[t][e] - mx); sc[t][e] = p; l += p; }
            l += __shfl_xor(l, 16); l += __shfl_xor(l, 32);
            lrun = lrun * alpha + l;
            bf16x8 pf[4];
#pragma unroll
            for (int j = 0; j < 4; ++j) pf[j] = pack8(sc[2 * j], sc[2 * j + 1]);
            { const unsigned q4 = ql >> 2, p = ql & 3, r0 = 8 * g + q4;
#pragma unroll
                for (int n = 0; n < 8; ++n) o[n] = o[n] * alpha;
#pragma unroll
                for (int j = 0; j < 4; ++j) if (j >= jlo && j <= jhi) {
                    s16x4 v0[8], v1[8];
#pragma unroll
                    for (int n = 0; n < 8; ++n) {
                        v0[n] = __builtin_amdgcn_ds_read_tr16_b64_v4i16((LAS s16x4*)(vb_ + offb(r0, 2 * n + (p >> 1)) + 8 * (p & 1) + 8192 * j));
                        v1[n] = __builtin_amdgcn_ds_read_tr16_b64_v4i16((LAS s16x4*)(vb_ + offb(r0 + 4, 2 * n + (p >> 1)) + 8 * (p & 1) + 8192 * j)); }
#pragma unroll
                    for (int n = 0; n < 8; ++n) { bf16x8 vf; vf[0] = v0[n][0]; vf[1] = v0[n][1]; vf[2] = v0[n][2]; vf[3] = v0[n][3]; vf[4] = v1[n][0]; vf[5] = v1[n][1]; vf[6] = v1[n][2]; vf[7] = v1[n][3];
                        o[n] = MFMA16(vf, pf[j], o[n]); } } }
            VM_WAIT(); __syncthreads();
        }
        { const float sc8 = H8_SCALE / lrun;
#pragma unroll
            for (int n = 0; n < 8; ++n) { int p8 = 0;
                p8 = __builtin_amdgcn_cvt_pk_fp8_f32(o[n][0] * sc8, o[n][1] * sc8, p8, false); p8 = __builtin_amdgcn_cvt_pk_fp8_f32(o[n][2] * sc8, o[n][3] * sc8, p8, true);
                *(int*)(HA8 + trow * D + head * 128 + 16 * n + 4 * g) = p8; } }
    }
    __syncthreads();
}

__device__ __forceinline__ void ss_unit(const Args& A, LAS unsigned char* lds, int unit, int lane, int wave) {
    unsigned char* ws = A.ws;
    const bf16_t *Q = (const bf16_t*)(ws + WS_Q), *K = (const bf16_t*)(ws + WS_K); bf16_t* SS = (bf16_t*)(ws + WS_SS);
    const float *U = (const float*)(ws + WS_U), *MX = (const float*)(ws + WS_MX), *WK = (const float*)(ws + WS_WK);
    float *RS = (float*)(ws + WS_DEN), *AC = (float*)(ws + WS_AC);
    const int c = unit & 63, bh = unit >> 6, b = bh >> 2, h = bh & 3;
    const int g = lane >> 4, r = lane & 15;
    const size_t t0 = (size_t)b * SEQ + 64 * c;
    LAS float* RSX = (LAS float*)(lds + 131072);
    LAS unsigned char* QS = lds; LAS unsigned char* KS = lds + 65536;
    __syncthreads();
#pragma unroll
    for (int ii = 0; ii < 8; ++ii) { const int row = 8 * wave + ii; const size_t go = (t0 + row) * D + h * 512 + 8 * (lane ^ (row & 15));
        GLDS16(Q + go, QS + row * 1024); GLDS16(K + go, KS + row * 1024); }
    VM_WAIT(); __syncthreads();
    { const int m = wave & 3, sh = wave >> 2;
        f32x4 acc[2];
#pragma unroll
        for (int n = 0; n < 2; ++n) acc[n] = (f32x4){0.f, 0.f, 0.f, 0.f};
#pragma unroll 8
        for (int ks = 0; ks < 16; ++ks) { const bf16x8 qfr = *(const LAS bf16x8*)(QS + (16 * m + r) * 1024 + 16 * ((4 * ks + g) ^ r));
#pragma unroll
            for (int n = 0; n < 2; ++n) { const bf16x8 kfr = *(const LAS bf16x8*)(KS + (32 * sh + 16 * n + r) * 1024 + 16 * ((4 * ks + g) ^ r)); acc[n] = MFMA16(kfr, qfr, acc[n]); } }
        const int j = 16 * m + r;
#pragma unroll
        for (int d = 0; d < 2; ++d) { const int ch = bh * 2 + d; const float mxj = MX[(size_t)ch * SEQ + 64 * c + j]; float rsum = 0.f;
#pragma unroll
            for (int n = 0; n < 2; ++n) { const int s0 = 32 * sh + 16 * n + 4 * g; const f32x4 us = *(const f32x4*)(U + (size_t)ch * SEQ + 64 * c + s0);
                float v[4];
#pragma unroll
                for (int e = 0; e < 4; ++e) { const int sx = s0 + e; const bool ok = d ? (sx >= j) : (sx <= j); v[e] = ok ? acc[n][e] * __expf(us[e] - mxj) : 0.f; rsum += v[e]; }
                u32x2 w; w.x = cvtpk(v[0], v[1]); w.y = cvtpk(v[2], v[3]);
                *(u32x2*)(SS + ((size_t)(ch * 64 + c) * 64 + j) * 64 + s0) = w; }
            rsum += __shfl_xor(rsum, 16); rsum += __shfl_xor(rsum, 32);
            if (g == 0) RSX[(d * 2 + sh) * 64 + j] = rsum; } }
    { const int d = wave >> 2, m = wave & 3, ch = bh * 2 + d, dk0 = 128 * m + 8 * r; float a8[8];
#pragma unroll
        for (int e = 0; e < 8; ++e) a8[e] = 0.f;
        f32x4 wk4[4]; u32x4 kk16[16];
#pragma unroll
        for (int i = 0; i < 4; ++i) wk4[i] = *(const f32x4*)(WK + (size_t)ch * SEQ + 64 * c + 16 * g + 4 * i);
#pragma unroll
        for (int i = 0; i < 16; ++i) kk16[i] = *(const LAS u32x4*)(KS + (16 * g + i) * 1024 + 16 * ((16 * m + r) ^ i));
#pragma unroll
        for (int i = 0; i < 16; ++i) { const float w = wk4[i >> 2][i & 3];
#pragma unroll
            for (int q = 0; q < 4; ++q) { a8[2 * q] += w * bflo(kk16[i][q]); a8[2 * q + 1] += w * bfhi(kk16[i][q]); } }
#pragma unroll
        for (int e = 0; e < 8; ++e) { a8[e] += __shfl_xor(a8[e], 16); a8[e] += __shfl_xor(a8[e], 32); }
        if (g == 0) { float* ap = AC + ((size_t)(ch * 64 + c)) * 512 + dk0; *(f32x4*)ap = (f32x4){a8[0], a8[1], a8[2], a8[3]}; *(f32x4*)(ap + 4) = (f32x4){a8[4], a8[5], a8[6], a8[7]}; } }
    __syncthreads();
    if (wave < 2) RS[(size_t)(bh * 2 + wave) * SEQ + 64 * c + lane] = RSX[(wave * 2) * 64 + lane] + RSX[(wave * 2 + 1) * 64 + lane];
    __syncthreads();
}

constexpr int ML_SMALL = 98304, ML_SMALL_STRIDE = 17408, ML_SMALL_END = ML_SMALL + 2 * ML_SMALL_STRIDE;
struct MlLaneOff { unsigned q[2], k[2]; };
__device__ __forceinline__ MlLaneOff ml_lane_off(int wave, int lane) {
    MlLaneOff o;
#pragma unroll
    for (int ii = 0; ii < 2; ++ii) { const int i = 2 * wave + ii;
        { const int row = 4 * i + (lane >> 4), cpos = lane & 15, sch = cpos ^ (row & 15); o.q[ii] = (unsigned)(row * D + 8 * sch) * 2u; }
        { const int line = 4 * i + (lane >> 4), cpos = lane & 15, c16 = cpos ^ (line & 15), row = 2 * line + (c16 >> 3), c8 = c16 & 7; o.k[ii] = (unsigned)(row * 64 + 8 * c8) * 2u; } }
    return o;
}
__device__ __forceinline__ void ml_issue_piece(const bf16_t* Q, const bf16_t* KT, LAS unsigned char* lds, const MlLaneOff& lo, int step, int slot, int dir, int b, int h, int bh, int wave) {
    const int ci = step >> 2, p = step & 3, c = dir ? 63 - ci : ci;
    LAS unsigned char* qp = lds + slot * 32768; LAS unsigned char* kp = qp + 16384;
    const char* qb_ = (const char*)(Q + ((size_t)b * SEQ + 64 * c) * D + h * 512 + 128 * p);
    const char* kb_ = (const char*)(KT + (((size_t)(bh * 64 + c)) * 512 + 128 * p) * 64);
#pragma unroll
    for (int ii = 0; ii < 2; ++ii) { const int i = 2 * wave + ii;
        GLDS16(qb_ + lo.q[ii], qp + i * 1024);
        GLDS16(kb_ + lo.k[ii], kp + i * 1024); }
}
__device__ __forceinline__ void ml_issue_small(const bf16_t* SS, const bf16_t* VT, const float* WI, const float* WK, const float* DEC, LAS unsigned char* lds, int ci, int dir, int ch, int bh, int dvblk, int wave, int lane) {
    const int c = dir ? 63 - ci : ci; LAS unsigned char* sm = lds + ML_SMALL + (ci & 1) * ML_SMALL_STRIDE;
    GLDS16(SS + ((size_t)(ch * 64 + c)) * 4096 + wave * 512 + lane * 8, sm + wave * 1024);
    GLDS16(VT + (((size_t)(bh * 64 + c)) * 512 + 64 * dvblk) * 64 + wave * 512 + lane * 8, sm + 8192 + wave * 1024);
    if (wave == 0) GLDS4(WI + (size_t)ch * SEQ + 64 * c + lane, sm + 16384);
    if (wave == 1) GLDS4(WK + (size_t)ch * SEQ + 64 * c + lane, sm + 16640);
    if (wave == 2) GLDS4(DEC + ch * 64 + c + lane, sm + 16896);
}
static_assert(ML_SMALL_END + 8192 <= MISC_OFF, "LDS map");
#define ML_BAR() do { asm volatile("" ::: "memory"); __builtin_amdgcn_s_barrier(); asm volatile("" ::: "memory"); } while (0)
#define ML_WAIT(n) asm volatile("s_waitcnt vmcnt(" #n ")" ::: "memory")

__device__ __forceinline__ void mlstm_nscan(const Args& A, int idx) {
    unsigned char* ws = A.ws;
    const float *AC = (const float*)(ws + WS_AC), *DEC = (const float*)(ws + WS_DEC); float* NC = (float*)(ws + WS_NC);
    const int ch = idx >> 9, dk = idx & 511, dir = ch & 1;
    float n = 0.f;
#pragma unroll 8
    for (int ci = 0; ci < 64; ++ci) { const int c = dir ? 63 - ci : ci; const size_t o = ((size_t)(ch * 64 + c)) * 512 + dk;
        NC[o] = n; n = DEC[ch * 64 + c] * n + AC[o]; }
}

__device__ __forceinline__ void mlstm_unit(const Args& A, LAS unsigned char* lds, int unit, int tid, int lane, int wave) {
    unsigned char* ws = A.ws;
    const bf16_t *Q = (const bf16_t*)(ws + WS_Q), *KT = (const bf16_t*)(ws + WS_KT), *VT = (const bf16_t*)(ws + WS_VT), *SS = (const bf16_t*)(ws + WS_SS);
    const float *WI = (const float*)(ws + WS_WI), *WK = (const float*)(ws + WS_WK), *DEC = (const float*)(ws + WS_DEC);
    const int ch = unit >> 3, dvblk = unit & 7, dir = ch & 1, bh = ch >> 1, b = bh >> 2, h = bh & 3;
    bf16_t* HOUT = (bf16_t*)(ws + (dir ? WS_AQ : WS_K));
    const int g = lane >> 4, r = lane & 15, dvt = wave & 3, dkh = wave >> 2;
    f32x4 C[16];
#pragma unroll
    for (int i = 0; i < 16; ++i) C[i] = (f32x4){0.f, 0.f, 0.f, 0.f};
    f32x4 hT[4];
#pragma unroll
    for (int m = 0; m < 4; ++m) hT[m] = (f32x4){0.f, 0.f, 0.f, 0.f};
    bf16x8 vw[2]; float dec = 0.f;
    unsigned qoff[2], koff[2][2];
#pragma unroll
    for (int kl = 0; kl < 2; ++kl) qoff[kl] = r * 256 + 16 * ((8 * dkh + 4 * kl + g) ^ r);
#pragma unroll
    for (int il = 0; il < 2; ++il)
#pragma unroll
        for (int k2 = 0; k2 < 2; ++k2) { const unsigned rl_ = 8 * (r >> 2) + (r & 3) + 4 * il, ln_ = rl_ >> 1, c16 = (rl_ & 1) * 8 + 4 * k2 + g; koff[il][k2] = 16384 + ln_ * 256 + 16 * (c16 ^ (ln_ & 15)) + 8192 * dkh; }
    ml_issue_small(SS, VT, WI, WK, DEC, lds, 0, dir, ch, bh, dvblk, wave, lane);
    const MlLaneOff lo = ml_lane_off(wave, lane);
    ml_issue_piece(Q, KT, lds, lo, 0, 0, dir, b, h, bh, wave);
    ml_issue_piece(Q, KT, lds, lo, 1, 1, dir, b, h, bh, wave);
    ML_WAIT(4); ML_BAR();
    int slot = 0;
    for (int ci = 0; ci < 64; ++ci) {
        const int c = dir ? 63 - ci : ci;
        LAS unsigned char* sm = lds + ML_SMALL + (ci & 1) * ML_SMALL_STRIDE;
#pragma unroll
        for (int p = 0; p < 4; ++p) {
            const int step = ci * 4 + p;
            const bool more = (step + 2 < 256);
            if (p == 0 && ci + 1 < 64) ml_issue_small(SS, VT, WI, WK, DEC, lds, ci + 1, dir, ch, bh, dvblk, wave, lane);
            if (more) { const int s2 = slot == 0 ? 2 : slot - 1; ml_issue_piece(Q, KT, lds, lo, step + 2, s2, dir, b, h, bh, wave); }
            LAS unsigned char* qp = lds + slot * 32768;
            if (p == 0) {
                dec = *(const LAS float*)(sm + 16896);
#pragma unroll
                for (int k2 = 0; k2 < 2; ++k2) {
                    const u32x4 vraw = *(const LAS u32x4*)(sm + 8192 + (16 * dvt + r) * 128 + 64 * k2 + 16 * g);
                    const f32x4 w0 = *(const LAS f32x4*)(sm + 16640 + (32 * k2 + 8 * g) * 4), w1 = *(const LAS f32x4*)(sm + 16640 + (32 * k2 + 8 * g + 4) * 4);
                    u32x4 ww; ww.x = cvtpk(bflo(vraw.x) * w0[0], bfhi(vraw.x) * w0[1]); ww.y = cvtpk(bflo(vraw.y) * w0[2], bfhi(vraw.y) * w0[3]);
                    ww.z = cvtpk(bflo(vraw.z) * w1[0], bfhi(vraw.z) * w1[1]); ww.w = cvtpk(bflo(vraw.w) * w1[2], bfhi(vraw.w) * w1[3]);
                    vw[k2] = __builtin_bit_cast(bf16x8, ww); }
            }
            bf16x8 qfr[2][4], kfr[4][2];
#pragma unroll
            for (int kl = 0; kl < 2; ++kl)
#pragma unroll
                for (int m = 0; m < 4; ++m) qfr[kl][m] = *(const LAS bf16x8*)(qp + qoff[kl] + 4096 * m);
#pragma unroll
            for (int il = 0; il < 4; ++il)
#pragma unroll
                for (int k2 = 0; k2 < 2; ++k2) kfr[il][k2] = *(const LAS bf16x8*)(qp + koff[il & 1][k2] + 4096 * (il >> 1));
            __builtin_amdgcn_sched_barrier(0);
#pragma unroll
            for (int kl = 0; kl < 2; ++kl) { const bf16x8 cf = pack8(C[4 * p + 2 * kl], C[4 * p + 2 * kl + 1]);
#pragma unroll
                for (int m = 0; m < 4; ++m) hT[m] = MFMA16(cf, qfr[kl][m], hT[m]); }
#pragma unroll
            for (int il = 0; il < 4; ++il) { C[4 * p + il] = C[4 * p + il] * dec;
#pragma unroll
                for (int k2 = 0; k2 < 2; ++k2) C[4 * p + il] = MFMA16(kfr[il][k2], vw[k2], C[4 * p + il]); }
            if (p == 3) {
                LAS unsigned char* xch = lds + ML_SMALL_END + (dvt * 2 + dkh) * 1024;
#pragma unroll
                for (int mm = 0; mm < 2; ++mm) { const f32x4 t4 = hT[2 * (1 - dkh) + mm]; u32x2 w; w.x = cvtpk(t4[0], t4[1]); w.y = cvtpk(t4[2], t4[3]); *(LAS u32x2*)(xch + mm * 512 + lane * 8) = w; }
                asm volatile("s_waitcnt lgkmcnt(0)" ::: "memory"); ML_BAR();
                const LAS unsigned char* xin = lds + ML_SMALL_END + (dvt * 2 + (1 - dkh)) * 1024;
#pragma unroll
                for (int mm = 0; mm < 2; ++mm) { const int m = 2 * dkh + mm;
                    const u32x2 pw = *(const LAS u32x2*)(xin + mm * 512 + lane * 8);
                    f32x4 hv = hT[m] + (f32x4){bflo(pw.x), bfhi(pw.x), bflo(pw.y), bfhi(pw.y)};
                    const float wi = *(const LAS float*)(sm + 16384 + (16 * m + r) * 4); hv = hv * wi;
#pragma unroll
                    for (int k2 = 0; k2 < 2; ++k2) { const bf16x8 sf = *(const LAS bf16x8*)(sm + (16 * m + r) * 128 + 64 * k2 + 16 * g);
                        const u32x4 vraw = *(const LAS u32x4*)(sm + 8192 + (16 * dvt + r) * 128 + 64 * k2 + 16 * g);
                        hv = MFMA16(__builtin_bit_cast(bf16x8, vraw), sf, hv); }
                    const size_t tok = (size_t)b * SEQ + 64 * c + 16 * m + r;
                    u32x2 w; w.x = cvtpk(hv[0], hv[1]); w.y = cvtpk(hv[2], hv[3]); *(u32x2*)(HOUT + tok * D + h * 512 + 64 * dvblk + 16 * dvt + 4 * g) = w; }
#pragma unroll
                for (int m = 0; m < 4; ++m) hT[m] = (f32x4){0.f, 0.f, 0.f, 0.f};
            }
            if (!more) { ML_WAIT(0); }
            else if (p == 0) { if (ci + 1 < 64) { if (wave < 3) ML_WAIT(7); else ML_WAIT(6); } else ML_WAIT(4); }
            else if (p == 3) { ML_WAIT(6); }
            else ML_WAIT(4);
            ML_BAR();
            slot = slot == 2 ? 0 : slot + 1;
        }
    }
    __syncthreads();
}

__device__ __forceinline__ void hm_rows(const Args& A, int lane, int gw, int NGW) {
    unsigned char* ws = A.ws;
    const bf16_t *HF = (const bf16_t*)(ws + WS_K), *HB = (const bf16_t*)(ws + WS_AQ), *SO = (const bf16_t*)(ws + WS_SO), *Q = (const bf16_t*)(ws + WS_Q); unsigned char* HM8 = ws + WS_HM8;
    const float *RS = (const float*)(ws + WS_DEN), *MR = (const float*)(ws + WS_MR), *WI = (const float*)(ws + WS_WI), *NC = (const float*)(ws + WS_NC);
    for (int row = gw; row < T; row += NGW) { const int b = row >> 12, s = row & 4095, c = s >> 6;
#pragma unroll
        for (int h = 0; h < 4; ++h) { const int chf = (b * 4 + h) * 2, chb = chf + 1;
            const size_t off = (size_t)row * D + h * 512 + 8 * lane;
            const u32x4 qv = *(const u32x4*)(Q + off);
            const float* nf = NC + ((size_t)(chf * 64 + c)) * 512 + 8 * lane; const float* nb = NC + ((size_t)(chb * 64 + c)) * 512 + 8 * lane;
            const f32x4 nf0 = *(const f32x4*)nf, nf1 = *(const f32x4*)(nf + 4), nb0 = *(const f32x4*)nb, nb1 = *(const f32x4*)(nb + 4);
            float df = bflo(qv.x) * nf0[0] + bfhi(qv.x) * nf0[1] + bflo(qv.y) * nf0[2] + bfhi(qv.y) * nf0[3] + bflo(qv.z) * nf1[0] + bfhi(qv.z) * nf1[1] + bflo(qv.w) * nf1[2] + bfhi(qv.w) * nf1[3];
            float db = bflo(qv.x) * nb0[0] + bfhi(qv.x) * nb0[1] + bflo(qv.y) * nb0[2] + bfhi(qv.y) * nb0[3] + bflo(qv.z) * nb1[0] + bfhi(qv.z) * nb1[1] + bflo(qv.w) * nb1[2] + bfhi(qv.w) * nb1[3];
            df = wave_sum(df); db = wave_sum(db);
            const float denf = WI[(size_t)chf * SEQ + s] * df + RS[(size_t)chf * SEQ + s], denb = WI[(size_t)chb * SEQ + s] * db + RS[(size_t)chb * SEQ + s];
            const float rdf = 1.0f / fmaxf(fabsf(denf), __expf(-MR[(size_t)chf * SEQ + s]));
            const float rdb = 1.0f / fmaxf(fabsf(denb), __expf(-MR[(size_t)chb * SEQ + s]));
            const u32x4 a = *(const u32x4*)(HF + off), bq = *(const u32x4*)(HB + off), so = *(const u32x4*)(SO + off);
            float v[8]; float ss = 0.f;
#pragma unroll
            for (int j = 0; j < 4; ++j) { v[2 * j] = bflo(a[j]) * rdf + bflo(bq[j]) * rdb; v[2 * j + 1] = bfhi(a[j]) * rdf + bfhi(bq[j]) * rdb; ss += v[2 * j] * v[2 * j] + v[2 * j + 1] * v[2 * j + 1]; }
            const float rs = 1.0f / sqrtf(wave_sum(ss) * (1.0f / 512.0f) + EPS);
            const f32x4 g0 = *(const f32x4*)(A.mnorm_g + h * 512 + 8 * lane), g1 = *(const f32x4*)(A.mnorm_g + h * 512 + 8 * lane + 4);
            const float r8 = rs * H8_SCALE; int p0 = 0, p1 = 0;
            p0 = __builtin_amdgcn_cvt_pk_fp8_f32(v[0] * r8 * g0[0] * bflo(so.x), v[1] * r8 * g0[1] * bfhi(so.x), p0, false); p0 = __builtin_amdgcn_cvt_pk_fp8_f32(v[2] * r8 * g0[2] * bflo(so.y), v[3] * r8 * g0[3] * bfhi(so.y), p0, true);
            p1 = __builtin_amdgcn_cvt_pk_fp8_f32(v[4] * r8 * g1[0] * bflo(so.z), v[5] * r8 * g1[1] * bfhi(so.z), p1, false); p1 = __builtin_amdgcn_cvt_pk_fp8_f32(v[6] * r8 * g1[2] * bflo(so.w), v[7] * r8 * g1[3] * bfhi(so.w), p1, true);
            u32x2 w; w.x = (unsigned)p0; w.y = (unsigned)p1;
            *(u32x2*)(HM8 + off) = w; } }
}

constexpr size_t WS_SC8 = 7 * MiB;
__device__ __forceinline__ float wave_max(float v) {
#pragma unroll
    for (int o = 1; o < 64; o <<= 1) v = __builtin_fmaxf(v, __shfl_xor(v, o));
    return v;
}
__device__ __forceinline__ unsigned pack_i8(const f32x4 v, float inv) {
    const int q0 = (int)__builtin_rintf(v[0] * inv), q1 = (int)__builtin_rintf(v[1] * inv), q2 = (int)__builtin_rintf(v[2] * inv), q3 = (int)__builtin_rintf(v[3] * inv);
    return ((unsigned)q0 & 0xffu) | (((unsigned)q1 & 0xffu) << 8) | (((unsigned)q2 & 0xffu) << 16) | ((unsigned)q3 << 24);
}
constexpr size_t WS_XI8 = WS_K;
constexpr size_t WS_SX = WS_SC8 + 128 * 1024;
__device__ __forceinline__ void rms2_rows(const Args& A, int lane, int gw, int NGW) {
    bf16_t* XN2 = (bf16_t*)(A.ws + WS_Q); unsigned char* XI8 = A.ws + WS_XI8; float* SX = (float*)(A.ws + WS_SX);
    f32x4 gv[8];
#pragma unroll
    for (int j = 0; j < 8; ++j) gv[j] = *(const f32x4*)(A.norm2_g + 4 * lane + 256 * j);
    f32x4 nx[8];
    if (gw < T) {
#pragma unroll
        for (int j = 0; j < 8; ++j) nx[j] = *(const f32x4*)(A.out + (size_t)gw * D + 4 * lane + 256 * j); }
    for (int row = gw; row < T; row += NGW) {
        f32x4 v[8]; float ss = 0.f;
#pragma unroll
        for (int j = 0; j < 8; ++j) { v[j] = nx[j]; ss += (v[j][0] * v[j][0] + v[j][1] * v[j][1]) + (v[j][2] * v[j][2] + v[j][3] * v[j][3]); }
        if (row + NGW < T) {
#pragma unroll
            for (int j = 0; j < 8; ++j) nx[j] = *(const f32x4*)(A.out + (size_t)(row + NGW) * D + 4 * lane + 256 * j); }
        const float rstd = 1.0f / sqrtf(wave_sum(ss) * (1.0f / D) + EPS);
        float am = 0.f;
#pragma unroll
        for (int j = 0; j < 8; ++j) { v[j] = v[j] * rstd * gv[j]; am = __builtin_fmaxf(__builtin_fmaxf(am, __builtin_fmaxf(__builtin_fabsf(v[j][0]), __builtin_fabsf(v[j][1]))), __builtin_fmaxf(__builtin_fabsf(v[j][2]), __builtin_fabsf(v[j][3]))); }
        am = __builtin_fmaxf(wave_max(am), 1e-30f); const float inv = 127.0f / am;
#pragma unroll
        for (int j = 0; j < 8; ++j) { const f32x4 o = v[j]; u32x2 w; w.x = cvtpk(o[0], o[1]); w.y = cvtpk(o[2], o[3]); *(u32x2*)(XN2 + (size_t)row * D + 4 * lane + 256 * j) = w;
            *(unsigned*)(XI8 + (size_t)row * D + 4 * lane + 256 * j) = pack_i8(o, inv); }
        if (lane == 0) SX[row] = am * (1.0f / 127.0f);
    }
}

__device__ __forceinline__ unsigned f2ord(float f) { const unsigned u = __float_as_uint(f); return u ^ ((u >> 31) ? 0xFFFFFFFFu : 0x80000000u); }
__device__ __forceinline__ float ord2f(unsigned k) { const unsigned u = (k & 0x80000000u) ? (k ^ 0x80000000u) : ~k; return __uint_as_float(u); }
#define INS16(L, xin) do { unsigned _x = (xin); _Pragma("unroll") for (int _i = 0; _i < 16; ++_i) { const unsigned _hi = max(L[_i], _x); _x = min(L[_i], _x); L[_i] = _hi; } } while (0)

__device__ __forceinline__ void bsort16(unsigned (&a)[16]) {
#pragma unroll
    for (int k = 2; k <= 16; k <<= 1)
#pragma unroll
        for (int j = k >> 1; j > 0; j >>= 1)
#pragma unroll
            for (int i = 0; i < 16; ++i) { const int l = i ^ j; if (l > i) { const bool desc = ((i & k) == 0); const unsigned x = a[i], y = a[l]; const unsigned hi = max(x, y), lo = min(x, y); a[i] = desc ? hi : lo; a[l] = desc ? lo : hi; } }
}
__device__ __forceinline__ void bmerge16(unsigned (&a)[16], const unsigned (&b)[16]) {
#pragma unroll
    for (int i = 0; i < 16; ++i) a[i] = max(a[i], b[15 - i]);
#pragma unroll
    for (int st = 8; st >= 1; st >>= 1)
#pragma unroll
        for (int i = 0; i < 16; ++i) if ((i & st) == 0) { const unsigned x = a[i], y = a[i + st]; a[i] = max(x, y); a[i + st] = min(x, y); }
}
__device__ __forceinline__ void topk_stage_keys(const Args& A, LAS unsigned char* lds, int h, int wave, int lane) {
    const bf16_t* KEYS = (const bf16_t*)(A.ws + WS_KEYS) + (size_t)h * 2 * 128 * 128;
    __syncthreads();
#pragma unroll
    for (int ii = 0; ii < 8; ++ii) { const int i = 8 * wave + ii, row = 4 * i + (lane >> 4), slot = lane & 15;
        GLDS16(KEYS + (size_t)row * 128 + 8 * (slot ^ (row & 15)), lds + i * 1024); }
    VM_WAIT(); __syncthreads();
}
__device__ __forceinline__ void topk_unit(const Args& A, LAS unsigned char* lds, int unit, int lane, int wave) {
    unsigned char* ws = A.ws;
    const bf16_t* PQ = (const bf16_t*)(ws + WS_XN);
    int* EXPI = (int*)(ws + WS_EXP); float* GATE = (float*)(ws + WS_GATE);
    const int h = unit & 7, tg = unit >> 3, t0 = tg * 32, tl = lane & 31, hh = lane >> 5;
    LAS unsigned* lw = (LAS unsigned*)(lds + 65536 + wave * 8192);
    unsigned L0[16], L1[16];
#pragma unroll
    for (int p = 0; p < 2; ++p) {
        f32x16 acc[4];
#pragma unroll
        for (int nb = 0; nb < 4; ++nb)
#pragma unroll
            for (int e = 0; e < 16; ++e) acc[nb][e] = 0.f;
#pragma unroll 4
        for (int ks = 0; ks < 8; ++ks) { const bf16x8 bq = *(const bf16x8*)((const unsigned char*)PQ + ((size_t)(((tg * 8 + h) * 2 + p) * 8 + ks)) * 1024 + lane * 16);
#pragma unroll
            for (int nb = 0; nb < 4; ++nb) { const bf16x8 ak = *(const LAS bf16x8*)(lds + p * 32768 + (32 * nb + tl) * 256 + 16 * ((2 * ks + hh) ^ (tl & 15)));
                acc[nb] = __builtin_amdgcn_mfma_f32_32x32x16_bf16(ak, bq, acc[nb], 0, 0, 0); } }
        unsigned L[16], G1[16];
#pragma unroll
        for (int nb = 0; nb < 4; ++nb) { unsigned Gn[16];
#pragma unroll
            for (int e = 0; e < 16; ++e) { const unsigned n = 32 * nb + (e & 3) + 8 * (e >> 2) + 4 * hh; Gn[e] = (f2ord(acc[nb][e]) & ~127u) | (127u - n); }
            bsort16(Gn);
            if (nb == 0) {
#pragma unroll
                for (int i = 0; i < 16; ++i) L[i] = Gn[i]; }
            else bmerge16(L, Gn); }
#pragma unroll
        for (int i = 0; i < 16; ++i) G1[i] = (unsigned)__shfl_xor(L[i], 32);
        bmerge16(L, G1);
#pragma unroll
        for (int i = 0; i < 16; ++i) { if (p == 0) L0[i] = L[i]; else L1[i] = L[i]; }
    }
    float v0[16], v1[16];
#pragma unroll
    for (int i = 0; i < 16; ++i) { v0[i] = ord2f(L0[i] & ~127u); v1[i] = ord2f(L1[i] & ~127u); lw[i * 64 + lane] = 127u - (L0[i] & 127u); lw[(16 + i) * 64 + lane] = 127u - (L1[i] & 127u); }
    unsigned Cn[16];
    { unsigned CC[64]; int cnt = 0;
#pragma unroll
        for (int i = 0; i < 16; ++i)
#pragma unroll
            for (int j = 0; j < 16; ++j) if ((i + 1) * (j + 1) <= 16) { CC[cnt] = (f2ord(v0[i] + v1[j]) & ~255u) | (255u - (unsigned)(i * 16 + j)); ++cnt; }
#pragma unroll
        for (int i = 50; i < 64; ++i) CC[i] = 0u;
#pragma unroll
        for (int gq = 0; gq < 4; ++gq) { unsigned Gn[16];
#pragma unroll
            for (int e = 0; e < 16; ++e) Gn[e] = CC[16 * gq + e];
            bsort16(Gn);
            if (gq == 0) {
#pragma unroll
                for (int i = 0; i < 16; ++i) Cn[i] = Gn[i]; }
            else bmerge16(Cn, Gn); } }
    float cv[16]; float sum = 0.f;
    const float m0 = ord2f(Cn[0] & ~255u);
#pragma unroll
    for (int rr = 0; rr < 16; ++rr) { cv[rr] = __expf(ord2f(Cn[rr] & ~255u) - m0); sum += cv[rr]; }
    const float rs = 1.0f / sum;
    if (hh == 0) {
        const size_t o = (size_t)(t0 + tl) * 128 + h * 16;
#pragma unroll
        for (int rr = 0; rr < 16; ++rr) { const unsigned code = 255u - (Cn[rr] & 255u), i = code >> 4, j = code & 15u;
            const unsigned e1 = lw[i * 64 + lane], e2 = lw[(16 + j) * 64 + lane];
            EXPI[o + rr] = (int)(e1 * 128u + e2); GATE[o + rr] = cv[rr] * rs; }
    }
}

__device__ __forceinline__ float gelu_erf(float v) { return 0.5f * v * (1.0f + erff(v * 0.70710678118654752f)); }
constexpr int P11_LW = 13312, P11_IDS = 512, P11_GT = 4608, P11_DOT = 8704;
__device__ __forceinline__ void convert_i8_rows(const float* src, unsigned char* dst, float* sc, int gw, int NGW, int lane) {
    for (int row = gw; row < 16384; row += NGW) {
        const float* s = src + (size_t)row * D + 4 * lane;
        f32x4 v[8]; float am = 0.f;
#pragma unroll
        for (int j = 0; j < 8; ++j) { v[j] = *(const f32x4*)(s + 256 * j);
            am = __builtin_fmaxf(__builtin_fmaxf(am, __builtin_fmaxf(__builtin_fabsf(v[j][0]), __builtin_fabsf(v[j][1]))), __builtin_fmaxf(__builtin_fabsf(v[j][2]), __builtin_fabsf(v[j][3]))); }
        am = __builtin_fmaxf(wave_max(am), 1e-30f);
        const float inv = 127.0f / am;
#pragma unroll
        for (int j = 0; j < 8; ++j) *(unsigned*)(dst + (size_t)row * D + 4 * lane + 256 * j) = pack_i8(v[j], inv);
        if (lane == 0) sc[row] = am * (1.0f / 127.0f);
    }
}
typedef unsigned u32x6 __attribute__((ext_vector_type(6)));
typedef float f32x16v __attribute__((ext_vector_type(16)));
typedef float f32x32v __attribute__((ext_vector_type(32)));
constexpr int F6_ROWB = 1536;
constexpr size_t WS_SCV = WS_SC8 + 64 * 1024;
__device__ __forceinline__ float f6_mag(int c) { return c < 16 ? 0.125f * (float)c : c < 24 ? 2.0f + 0.25f * (float)(c - 16) : 4.0f + 0.5f * (float)(c - 24); }
__device__ __forceinline__ void convert_fp6_rows(const float* src, unsigned char* dst, float* sc, LAS float* scr, int gw, int NGW, int lane) {
    LAS int* tab = (LAS int*)(scr + 64 * 36);
    int cfs[32];
    { f32x16v ta, tb;
#pragma unroll
      for (int i = 0; i < 16; ++i) { ta[i] = f6_mag(i); tb[i] = f6_mag(16 + i); }
      asm volatile("" : "+v"(ta), "+v"(tb));
      const u32x6 tp = __builtin_amdgcn_cvt_scalef32_2xpk16_fp6_f32(ta, tb, 1.0f);
      const f32x32v tr = __builtin_amdgcn_cvt_scalef32_pk32_f32_fp6(tp, 1.0f);
#pragma unroll
      for (int k = 0; k < 32; ++k) { const float y = tr[k]; const int sidx = (int)(y < 2.0f ? y * 8.0f : y < 4.0f ? 16.0f + (y - 2.0f) * 4.0f : 24.0f + (y - 4.0f) * 2.0f) & 31; if (lane == 0) tab[sidx] = k; }
#pragma unroll
      for (int q = 0; q < 32; ++q) cfs[q] = tab[q]; }
    const int slot = (lane >> 1) & 7, half = lane & 1;
    const int off16 = 384 * (lane >> 4) + (half ? 256 : 0) + 16 * slot, off8 = 384 * (lane >> 4) + 128 + 16 * slot + (half ? 8 : 0);
    for (int row = gw; row < 16384; row += NGW) {
        const float* s = src + (size_t)row * D;
#pragma unroll
        for (int j = 0; j < 8; ++j) { const int c = 4 * lane + 256 * j; *(LAS f32x4*)(scr + 36 * (c >> 5) + (c & 31)) = *(const f32x4*)(s + c); }
        float v[32]; float am = 0.f;
#pragma unroll
        for (int q = 0; q < 32; ++q) { v[q] = scr[36 * lane + cfs[q]]; am = __builtin_fmaxf(am, __builtin_fabsf(v[q])); }
        am = __builtin_fmaxf(wave_max(am), 1e-30f);
        const float inv = 7.5f / am;
        f32x16v a, b;
#pragma unroll
        for (int i = 0; i < 16; ++i) { a[i] = v[i] * inv; b[i] = v[16 + i] * inv; }
        const u32x6 p = __builtin_amdgcn_cvt_scalef32_2xpk16_fp6_f32(a, b, 1.0f);
        unsigned char* d = dst + (size_t)row * F6_ROWB;
        *(u32x4*)(d + off16) = half ? (u32x4){p[2], p[3], p[4], p[5]} : (u32x4){p[0], p[1], p[2], p[3]};
        *(u32x2*)(d + off8) = half ? (u32x2){p[0], p[1]} : (u32x2){p[4], p[5]};
        if (lane == 0) sc[row] = am * (1.0f / 7.5f);
    }
}
__device__ __forceinline__ void ld_quad8(u32x4 (&r)[4][2], const unsigned char* TAB, const u32x4 ids, unsigned colb) {
#pragma unroll
    for (int e = 0; e < 4; ++e) { const unsigned char* p = TAB + (ids[e] * (unsigned)D + colb);
        r[e][0] = *(const u32x4*)p; r[e][1] = *(const u32x4*)(p + 128); }
}
__device__ __forceinline__ void gather_lanes8(const Args& A, LAS unsigned char* ldsw, int lane, int gw, int NGW) {
    unsigned char* ws = A.ws;
    const unsigned char *PU = ws + WS_KT, *PV = ws + WS_VT, *XI8 = ws + WS_XI8; const float *SCU = (const float*)(ws + WS_SC8), *SX = (const float*)(ws + WS_SX), *SCV = (const float*)(ws + WS_SCV);
    const int* EXPI = (const int*)(ws + WS_EXP); const float* GATE = (const float*)(ws + WS_GATE);
    LAS unsigned* KEY = (LAS unsigned*)ldsw; LAS unsigned* IDS = (LAS unsigned*)(ldsw + P11_IDS); LAS float* GT = (LAS float*)(ldsw + P11_GT); LAS int* DOT = (LAS int*)(ldsw + P11_DOT);
    const int tj = lane >> 3, l8 = lane & 7;
    const int el4 = ((lane & 1) << 1) | ((lane & 2) >> 1);
    for (int tb = gw * 8; tb < T; tb += NGW * 8) {
        unsigned idA[8], idB[8]; float gA[8], gB[8];
#pragma unroll
        for (int i = 0; i < 8; ++i) { const size_t o = (size_t)(tb + i) * 128; idA[i] = (unsigned)EXPI[o + lane]; idB[i] = (unsigned)EXPI[o + 64 + lane]; gA[i] = GATE[o + lane]; gB[i] = GATE[o + 64 + lane]; }
#pragma unroll
        for (int i = 0; i < 8; ++i) { const unsigned ida = idA[i], idb = idB[i]; const float ga = gA[i], gb = gB[i];
            const unsigned ka = (ida << 7) | (unsigned)lane, kb = (idb << 7) | (unsigned)(64 + lane);
            KEY[lane] = ka; KEY[64 + lane] = kb;
            unsigned ra = 0, rb = 0;
#pragma unroll 4
            for (int j4 = 0; j4 < 32; ++j4) { const u32x4 kk = *(const LAS u32x4*)(KEY + 4 * j4);
#pragma unroll
                for (int q = 0; q < 4; ++q) { const unsigned kv = kk[q]; ra += (kv < ka) ? 1u : 0u; rb += (kv < kb) ? 1u : 0u; } }
            IDS[i * 128 + ra] = ida; GT[i * 128 + ra] = ga; IDS[i * 128 + rb] = idb; GT[i * 128 + rb] = gb;
            DOT[i * 128 + lane] = 0; DOT[i * 128 + 64 + lane] = 0; }
        const LAS unsigned* myids = IDS + tj * 128; LAS int* mydot = DOT + tj * 128; const LAS float* myact = GT + tj * 128;
        const size_t trow = (size_t)(tb + tj) * D;
        u32x4 xnx[2];
#pragma unroll
        for (int c = 0; c < 2; ++c) xnx[c] = *(const u32x4*)(XI8 + trow + 16u * l8 + 128 * c);
#pragma unroll 1
        for (int sw = 0; sw < 8; ++sw) { const unsigned colb = 256u * sw + 16u * l8;
            u32x4 xi[2];
#pragma unroll
            for (int c = 0; c < 2; ++c) { xi[c] = xnx[c]; xnx[c] = *(const u32x4*)(XI8 + trow + ((colb + 256u) & 2047u) + 128 * c); }
            u32x4 r0_[4][2], r1_[4][2], r2_[4][2], r3_[4][2];
            ld_quad8(r0_, PU, *(const LAS u32x4*)(myids), colb); ld_quad8(r1_, PU, *(const LAS u32x4*)(myids + 4), colb); ld_quad8(r2_, PU, *(const LAS u32x4*)(myids + 8), colb);
#define U8_COMPUTE(R, Q) do { int part[4]; \
            _Pragma("unroll") for (int e = 0; e < 4; ++e) { int a1 = 0; \
                _Pragma("unroll") for (int c = 0; c < 2; ++c) _Pragma("unroll") for (int w = 0; w < 4; ++w) a1 = __builtin_amdgcn_sdot4((int)R[e][c][w], (int)xi[c][w], a1, false); \
                part[e] = a1; } \
            _Pragma("unroll") for (int q2 = 0; q2 < 2; ++q2) { const int send = (lane & 1) ? part[q2] : part[q2 + 2], keep = (lane & 1) ? part[q2 + 2] : part[q2]; part[q2] = keep + __shfl_xor(send, 1); } \
            { const int send = (lane & 2) ? part[0] : part[1], keep = (lane & 2) ? part[1] : part[0]; part[0] = keep + __shfl_xor(send, 2); } \
            int dt = part[0]; dt += __shfl_xor(dt, 4); \
            if (l8 < 4) mydot[4 * (Q) + el4] += dt; } while (0)
#pragma unroll 1
            for (int q = 0; q < 28; q += 4) {
                ld_quad8(r3_, PU, *(const LAS u32x4*)(myids + 4 * (q + 3)), colb);
                U8_COMPUTE(r0_, q);
                ld_quad8(r0_, PU, *(const LAS u32x4*)(myids + 4 * (q + 4)), colb);
                U8_COMPUTE(r1_, q + 1);
                ld_quad8(r1_, PU, *(const LAS u32x4*)(myids + 4 * (q + 5)), colb);
                U8_COMPUTE(r2_, q + 2);
                ld_quad8(r2_, PU, *(const LAS u32x4*)(myids + 4 * (q + 6)), colb);
                U8_COMPUTE(r3_, q + 3);
            }
            ld_quad8(r3_, PU, *(const LAS u32x4*)(myids + 4 * 31), colb);
            U8_COMPUTE(r0_, 28); U8_COMPUTE(r1_, 29); U8_COMPUTE(r2_, 30); U8_COMPUTE(r3_, 31);
#undef U8_COMPUTE
        }
        { float su0[8], su1[8], sv0[8], sv1[8], sx8[8];
#pragma unroll
          for (int i = 0; i < 8; ++i) { const unsigned id0 = IDS[i * 128 + lane], id1 = IDS[i * 128 + 64 + lane]; su0[i] = SCU[id0]; su1[i] = SCU[id1]; sv0[i] = SCV[id0]; sv1[i] = SCV[id1]; sx8[i] = SX[tb + i]; }
#pragma unroll
          for (int i = 0; i < 8; ++i) { const float d0 = (float)DOT[i * 128 + lane] * (su0[i] * sx8[i]), d1 = (float)DOT[i * 128 + 64 + lane] * (su1[i] * sx8[i]);
            GT[i * 128 + lane] = gelu_erf(d0) * GT[i * 128 + lane] * sv0[i]; GT[i * 128 + 64 + lane] = gelu_erf(d1) * GT[i * 128 + 64 + lane] * sv1[i]; } }
#pragma unroll 1
        for (int sw = 0; sw < 4; ++sw) { const unsigned ofs = 384u * sw + 16u * l8; const int colb = 512 * sw + 64 * l8;
            f32x2v acc[32];
#pragma unroll
            for (int c = 0; c < 32; ++c) acc[c] = (f32x2v){0.f, 0.f};
            u32x4 r0_[2][3], r1_[2][3], r2_[2][3];
#define V6_LOAD(R, Q) do { const u32x2 id2 = *(const LAS u32x2*)(myids + 2 * (Q)); \
            _Pragma("unroll") for (int e = 0; e < 2; ++e) { const unsigned char* p = PV + (id2[e] * (unsigned)F6_ROWB + ofs); \
                R[e][0] = *(const u32x4*)p; R[e][1] = *(const u32x4*)(p + 128); R[e][2] = *(const u32x4*)(p + 256); } } while (0)
#define V6_COMPUTE(R, Q) do { const f32x2v av = *(const LAS f32x2v*)(myact + 2 * (Q)); \
            _Pragma("unroll") for (int e = 0; e < 2; ++e) { const float a = av[e]; \
                { const f32x32v ra = __builtin_amdgcn_cvt_scalef32_pk32_f32_fp6((u32x6){R[e][0][0], R[e][0][1], R[e][0][2], R[e][0][3], R[e][1][0], R[e][1][1]}, 1.0f); \
                  _Pragma("unroll") for (int i = 0; i < 16; ++i) acc[i] += (f32x2v){ra[2 * i], ra[2 * i + 1]} * a; } \
                { const f32x32v rb = __builtin_amdgcn_cvt_scalef32_pk32_f32_fp6((u32x6){R[e][1][2], R[e][1][3], R[e][2][0], R[e][2][1], R[e][2][2], R[e][2][3]}, 1.0f); \
                  _Pragma("unroll") for (int i = 0; i < 16; ++i) acc[16 + i] += (f32x2v){rb[2 * i], rb[2 * i + 1]} * a; } } } while (0)
            V6_LOAD(r0_, 0); V6_LOAD(r1_, 1);
#pragma unroll 1
            for (int q = 0; q < 60; q += 3) {
                V6_LOAD(r2_, q + 2); V6_COMPUTE(r0_, q);
                V6_LOAD(r0_, q + 3); V6_COMPUTE(r1_, q + 1);
                V6_LOAD(r1_, q + 4); V6_COMPUTE(r2_, q + 2);
            }
            V6_LOAD(r2_, 62); V6_COMPUTE(r0_, 60);
            V6_LOAD(r0_, 63); V6_COMPUTE(r1_, 61);
            V6_COMPUTE(r2_, 62); V6_COMPUTE(r0_, 63);
#undef V6_LOAD
#undef V6_COMPUTE
#pragma unroll
            for (int q4 = 0; q4 < 16; ++q4) { float* oq = A.out + trow + colb + 4 * q4; f32x4 a = *(const f32x4*)oq;
                a[0] += acc[2 * q4][0]; a[1] += acc[2 * q4][1]; a[2] += acc[2 * q4 + 1][0]; a[3] += acc[2 * q4 + 1][1];
                *(f32x4*)oq = a; }
        }
    }
}
__global__ void __launch_bounds__(NTHR, 2) fwd_kernel(Args A) {
    extern __shared__ __attribute__((aligned(16))) unsigned char lds_raw[];
    LAS unsigned char* lds = (LAS unsigned char*)lds_raw;
    const int tid = threadIdx.x, lane = tid & 63, wave = __builtin_amdgcn_readfirstlane(tid >> 6);
    const int G = gridDim.x, bx = blockIdx.x;
    const int vcu = (G % 8 == 0) ? (bx % 8) * (G / 8) + bx / 8 : bx;
    const int gw = bx * NWAVES + wave, NGW = G * NWAVES;
    unsigned char* ws = A.ws;
    volatile LAS unsigned* MISC = (volatile LAS unsigned*)(lds + MISC_OFF);
    if (tid < 16) MISC[tid] = 0u;
    __syncthreads();
    const int lo = A.ph_lo, hi = A.ph_hi;
    XcdBarrier bar; bar.bar = (unsigned*)(ws + WS_CTL) + CW_BAR; bar.x = 0; bar.st = nullptr;
    if (hi - lo > 1) bar = xcd_barrier_post((unsigned*)(ws + WS_CTL) + CW_BAR, MISC + 8);
#ifndef ONLY_PHASE
#define ONLY_PHASE -1
#endif
#define IN(k) ((ONLY_PHASE < 0 || ONLY_PHASE == (k)) && lo <= (k) && (k) < hi)
#define SEAM(k) do { if (IN(k) && IN((k) + 1)) xcd_barrier(bar); } while (0)

    if (IN(0)) { p0_prologue(A, lds, tid, lane, wave, G); }
    SEAM(0);
    if (IN(1)) {
        if (bx < 32) gate_scan(A, lds, bx, tid, lane, wave);
        EpiInProj E{ws, (bf16_t*)A.out, 0, 1.0f};
        { pg8::Gemm g{(const bf16_t*)(ws + WS_XN), (const bf16_t*)(ws + WS_WIN16), T, N16, D}; pg8::StaticOrder S; S.init(T, N16, G, bx);
          pg8::gemm_phase<EpiInProj, pg8::StaticOrder, false, false>(lds, g, S, E, nullptr); }
        E.pn0 = N16 / 256; E.osc = 1.0f / (XN8_SCALE * WIN8_SCALE);
        { pg8::Gemm g{(const bf16_t*)(ws + WS_XN8), (const bf16_t*)(ws + WS_WIN8), T, 15360 - N16, D / 2}; pg8::StaticOrder S; S.init(T, 15360 - N16, G, bx);
          pg8::gemm_phase<EpiInProj, pg8::StaticOrder, false, true>(lds, g, S, E, nullptr);
#ifdef DBG_F8TWICE
          pg8::gemm_phase<EpiInProj, pg8::StaticOrder, false, true>(lds, g, S, E, nullptr);
#endif
          }
    }
    SEAM(1);
    if (IN(2)) {
        attn_phase(A, lds, vcu, G, tid, lane, wave);
#ifdef DBG_ATT2
        attn_phase(A, lds, vcu, G, tid, lane, wave);
#endif
        for (int u = vcu; u < 1024; u += G) ss_unit(A, lds, u, lane, wave);
#ifdef DBG_SS2
        for (int u = vcu; u < 1024; u += G) ss_unit(A, lds, u, lane, wave);
#endif
        __syncthreads();
        LAS float* scr = (LAS float*)(lds + wave * 8704);
        constexpr int NBLK = D / 32, NIT = (D / 64) * NBLK;
        for (int it = gw; it < 4 * NIT; it += NGW) { const int w = it / NIT, r = it % NIT;
            if (w < 2 || (P6_FP8 && w == 2)) transpose_item8<false>(w == 0 ? A.w_a : w == 1 ? A.w_m : A.w_out, D, D, NBLK, ws + (w == 0 ? WS_WA : w == 1 ? WS_WM : WS_WO), scr, r, lane);
            else transpose_item(w == 2 ? A.w_out : A.peer_wq, D, D, NBLK, (bf16_t*)(ws + (w == 2 ? WS_WO : WS_WQ)), scr, r, lane, false); }
        convert_stream(A.peer_keys, (bf16_t*)(ws + WS_KEYS), (size_t)16 * 128 * 128, bx * NTHR + tid, G * NTHR);
    }
    SEAM(2);
    if (IN(3)) {
        if (wave == 0) for (int idx = bx * 64 + lane; idx < 32 * 512; idx += G * 64) mlstm_nscan(A, idx);
        for (int u = vcu; u < 256; u += G) mlstm_unit(A, lds, u, tid, lane, wave);
    }
    SEAM(3);
    if (IN(4)) {
        hm_rows(A, lane, gw, NGW);
        convert_i8_rows(A.peer_u, ws + WS_KT, (float*)(ws + WS_SC8), gw, NGW, lane);
        convert_fp6_rows(A.peer_v, ws + WS_VT, (float*)(ws + WS_SCV), (LAS float*)(lds + wave * 9472), gw, NGW, lane);
    }
    SEAM(4);
    if (IN(5)) {
        pg8::StaticOrder S; S.init(T, D, G, bx);
        { pg8::Gemm g{(const bf16_t*)(ws + WS_HA8), (const bf16_t*)(ws + WS_WA), T, D, D / 2, (const bf16_t*)(ws + WS_HM8), (const bf16_t*)(ws + WS_WM)};
          EpiMerge2 E{(const bf16_t*)A.out + (size_t)T * D, (const bf16_t*)A.out, (bf16_t*)(ws + WS_SO), (P6_FP8 ? H8_SCALE : 1.0f) / (H8_SCALE * WIN8_SCALE)};
          pg8::gemm_phase<EpiMerge2, pg8::StaticOrder, false, true>(lds, g, S, E, nullptr); }
    }
    SEAM(5);
    if (IN(6)) {
        pg8::StaticOrder S; S.init(T, D, G, bx);
#if P6_FP8
        pg8::Gemm g{(const bf16_t*)(ws + WS_SO), (const bf16_t*)(ws + WS_WO), T, D, D / 2}; EpiResid E{A.x, A.out, 1.0f / (H8_SCALE * WIN8_SCALE)};
        pg8::gemm_phase<EpiResid, pg8::StaticOrder, false, true>(lds, g, S, E, nullptr);
#else
        pg8::Gemm g{(const bf16_t*)(ws + WS_SO), (const bf16_t*)(ws + WS_WO), T, D, D}; EpiResid E{A.x, A.out, 1.0f};
        pg8::gemm_phase<EpiResid, pg8::StaticOrder, false, false>(lds, g, S, E, nullptr);
#endif
    }
    SEAM(6);
    if (IN(7)) { rms2_rows(A, lane, gw, NGW); }
    SEAM(7);
    if (IN(8)) {
        pg8::StaticOrder S; S.init(T, D, G, bx);
        pg8::Gemm g{(const bf16_t*)(ws + WS_Q), (const bf16_t*)(ws + WS_WQ), T, D, D}; EpiPlainBf16 E{(bf16_t*)(ws + WS_XN)};
        pg8::gemm_phase<EpiPlainBf16, pg8::StaticOrder, false>(lds, g, S, E, nullptr);
    }
    SEAM(8);
    if (IN(9)) {
        if (G % 8 == 0) { const int h = bx & 7; topk_stage_keys(A, lds, h, wave, lane);
            for (int tg = (bx >> 3) * NWAVES + wave; tg < 512; tg += (G >> 3) * NWAVES) topk_unit(A, lds, tg * 8 + h, lane, wave); }
        else for (int h = 0; h < 8; ++h) { topk_stage_keys(A, lds, h, wave, lane);
            for (int tg = gw; tg < 512; tg += NGW) topk_unit(A, lds, tg * 8 + h, lane, wave); }
        __syncthreads();
    }
    SEAM(9);
    if (IN(10)) { gather_lanes8(A, lds + wave * P11_LW, lane, gw, NGW); }
}

#ifndef N_LAUNCHES
#define N_LAUNCHES 1
#endif
extern "C" void kernel_launch(void* const* d_in, const int* in_sizes, int n_in, void* d_out, int out_size, void* d_ws, size_t ws_size, hipStream_t stream) {
    static int grid = 0;
    if (grid == 0) {
        if (n_in != 17 || in_sizes[0] != T * D || out_size != T * D || ws_size < WS_END) { fprintf(stderr, "kernel_launch: unexpected shapes (n_in %d, in0 %d, out %d, ws %zu): nothing launched\n", n_in, n_in > 0 ? in_sizes[0] : -1, out_size, ws_size); grid = -1; return; }
        int dev = 0, cus = 0, per_cu = 0;
        if (hipGetDevice(&dev) != hipSuccess || hipDeviceGetAttribute(&cus, hipDeviceAttributeMultiprocessorCount, dev) != hipSuccess) { grid = -1; return; }
        if (hipFuncSetAttribute((const void*)fwd_kernel, hipFuncAttributeMaxDynamicSharedMemorySize, LDS_BYTES) != hipSuccess) { fprintf(stderr, "kernel_launch: hipFuncSetAttribute failed\n"); grid = -1; return; }
        if (hipOccupancyMaxActiveBlocksPerMultiprocessor(&per_cu, (const void*)fwd_kernel, NTHR, LDS_BYTES) != hipSuccess || per_cu < 1) { fprintf(stderr, "kernel_launch: occupancy query reports %d\n", per_cu); }
        (void)hipGetLastError();
        grid = cus;
    }
    if (grid < 0) return;
    if (hipMemsetAsync((char*)d_ws + WS_CTL, 0, CTL_ZERO_BYTES, stream) != hipSuccess) return;
    Args a{};
    a.x = (const float*)d_in[0]; a.norm1_g = (const float*)d_in[1]; a.w_in = (const float*)d_in[2]; a.gate_b = (const float*)d_in[3]; a.mnorm_g = (const float*)d_in[4]; a.w_m = (const float*)d_in[5];
    a.gq = (const float*)d_in[6]; a.gk = (const float*)d_in[7]; a.sink = (const float*)d_in[8]; a.rel_bias = (const float*)d_in[9]; a.w_a = (const float*)d_in[10]; a.w_out = (const float*)d_in[11];
    a.norm2_g = (const float*)d_in[12]; a.peer_wq = (const float*)d_in[13]; a.peer_keys = (const float*)d_in[14]; a.peer_u = (const float*)d_in[15]; a.peer_v = (const float*)d_in[16];
    a.out = (float*)d_out; a.ws = (unsigned char*)d_ws;
#ifndef DBG_LAST
#define DBG_LAST (NPHASE - 1)
#endif
#ifndef DBG_REPEAT
#define DBG_REPEAT -1
#endif
    for (int li = 0; li < N_LAUNCHES && li <= DBG_LAST; ++li) {
        a.ph_lo = (N_LAUNCHES == 1) ? 0 : li; a.ph_hi = (N_LAUNCHES == 1) ? NPHASE : li + 1;
        hipLaunchKernelGGL(fwd_kernel, dim3(grid), dim3(NTHR), LDS_BYTES, stream, a);
        if (N_LAUNCHES > 1 && DBG_REPEAT >= 0 && DBG_REPEAT < 10 && li == DBG_REPEAT) hipLaunchKernelGGL(fwd_kernel, dim3(grid), dim3(NTHR), LDS_BYTES, stream, a);
        if (N_LAUNCHES > 1 && DBG_REPEAT == 10 && li == 10) for (int k = 6; k <= 10; ++k) { a.ph_lo = k; a.ph_hi = k + 1; hipLaunchKernelGGL(fwd_kernel, dim3(grid), dim3(NTHR), LDS_BYTES, stream, a); }
    }
}
```

```cpp
#include <hip/hip_runtime.h>
#include <cstdio>

namespace pg8 {
#define PG8_LAS __attribute__((address_space(3)))
typedef unsigned short bf16_t;
typedef short bf16x8 __attribute__((ext_vector_type(8)));
typedef float f32x4 __attribute__((ext_vector_type(4)));
typedef unsigned u32x4 __attribute__((ext_vector_type(4)));
constexpr int BM = 256, BK = 64, HALF = 128, HTB = HALF * BK * 2  , STAGE_BYTES = 8 * HTB, NXCD = 8, WGM = 8;

__host__ __device__ __forceinline__ int lds_byte(int r, int c) { const int st = (r >> 4) * 2 + (c >> 5), rr = r & 15, cc = c & 31, ob = rr * 64 + cc * 2; return st * 1024 + (ob ^ (((ob >> 9) & 1) << 5)); }
__host__ __device__ __forceinline__ void stage_rc(int b, int& R, int& C) { const int st = b / 1024, sb = b % 1024, swz = sb ^ (((sb >> 9) & 1) << 5); R = (st >> 1) * 16 + swz / 64; C = (st & 1) * 32 + (swz % 64) / 2; }
__host__ __device__ __forceinline__ int perm32(int rho) { const int n = rho >> 4, i = rho & 15; return 8 * (i >> 2) + 4 * n + (i & 3); }

struct Unit { int pm, pn; };
struct Gemm { const bf16_t* A; const bf16_t* Bt; int M, N, K; const bf16_t* A2 = nullptr; const bf16_t* Bt2 = nullptr; };

struct StaticOrder {
    int nM, nN, nwg, G, c;
    __host__ __device__ void init(int M, int N, int G_, int c_) { nM = M / BM; nN = N / BM; nwg = nM * nN; G = G_; c = c_; }
    __host__ __device__ bool next(int i, Unit& u) const {
        const long L = (long)i * G + c; if (L >= nwg) return false;
        int wgid = (int)L; { const int q = nwg / NXCD, r = nwg % NXCD, xcd = wgid % NXCD, off = wgid / NXCD; wgid = (xcd < r ? xcd * (q + 1) : r * (q + 1) + (xcd - r) * q) + off; }
        const int nig = WGM * nN, gid = wgid / nig, fm = gid * WGM, gsz = (nM - fm) < WGM ? (nM - fm) : WGM;
        u.pm = fm + ((wgid % nig) % gsz); u.pn = (wgid % nig) / gsz; return true;
    }
    __device__ __forceinline__ void a_ready(const Unit&) const {}
    __device__ __forceinline__ void done(const Unit&) const {}
};
struct CountedOrder : StaticOrder {
    const unsigned* ready; unsigned need; unsigned* tmo;
    __device__ __forceinline__ void a_ready(const Unit& u) const {
        if (threadIdx.x < 64) {
            const unsigned long long t0 = __builtin_amdgcn_s_memrealtime(); unsigned polls = 0;
            while ((unsigned)__builtin_amdgcn_readfirstlane(__hip_atomic_load(ready + 64 * u.pm, __ATOMIC_RELAXED, __HIP_MEMORY_SCOPE_AGENT)) < need) {
                if ((++polls & 255u) == 0u && __builtin_amdgcn_readfirstlane(__hip_atomic_load(tmo, __ATOMIC_RELAXED, __HIP_MEMORY_SCOPE_AGENT)) != 0u) break;
                if (__builtin_amdgcn_s_memrealtime() - t0 > 2000000ull) {
                    if (threadIdx.x == 0) { unsigned expect = 0u; __hip_atomic_compare_exchange_strong(tmo + 1, &expect, 0x600u | (unsigned)(u.pm & 0xff), __ATOMIC_RELAXED, __ATOMIC_RELAXED, __HIP_MEMORY_SCOPE_AGENT); __hip_atomic_store(tmo, 1u, __ATOMIC_RELAXED, __HIP_MEMORY_SCOPE_AGENT); }
                    break; }
                __builtin_amdgcn_s_sleep(2); }
            __builtin_amdgcn_fence(__ATOMIC_ACQUIRE, "agent");
            asm volatile("s_waitcnt vmcnt(0)" ::: "memory");
        }
#if !defined(BROKEN_HOOK_NO_BARRIER)
        asm volatile("" ::: "memory"); __builtin_amdgcn_s_barrier(); asm volatile("" ::: "memory");
#endif
    }
};

__device__ __forceinline__ unsigned cvt_pk_bf16(float lo, float hi) { unsigned r; asm volatile("v_cvt_pk_bf16_f32 %0, %1, %2" : "=v"(r) : "v"(lo), "v"(hi)); return r; }
typedef float f32x2 __attribute__((ext_vector_type(2)));
__device__ __forceinline__ f32x2 gelu_pk(f32x2 v) {
    const f32x2 av = __builtin_elementwise_abs(v), d = av * 0.2316418882f + 1.0f;
    f32x2 t; t.x = __builtin_amdgcn_rcpf(d.x); t.y = __builtin_amdgcn_rcpf(d.y);
    f32x2 q = t * 0.5307027145f + (-0.7265760135f); q = q * t + 0.7107068705f; q = q * t + (-0.142248368f); q = q * t + 0.127414796f; q = q * t;
    const f32x2 s = (v * v) * (-0.72134752044f);
    f32x2 e; e.x = __builtin_amdgcn_exp2f(s.x); e.y = __builtin_amdgcn_exp2f(s.y);
    const f32x2 m = v * (q * e), r = v - m;
    f32x2 o; o.x = v.x < 0.f ? m.x : r.x; o.y = v.y < 0.f ? m.y : r.y; return o;
}

typedef int i32x4 __attribute__((ext_vector_type(4)));
typedef int i32x8 __attribute__((ext_vector_type(8)));
typedef int i32x6 __attribute__((ext_vector_type(6)));
template <class Epi, class Sched, bool STAMP = false, bool F8 = false, bool F6 = false>
__device__ __forceinline__ void gemm_phase(PG8_LAS unsigned char* lds, const Gemm g, const Sched& S, const Epi& E, unsigned long long* stamps) {
    const int tid = threadIdx.x, wid = __builtin_amdgcn_readfirstlane(tid >> 6), lane = tid & 63, wr = wid >> 2, wc = wid & 3, fr = lane & 15, fq = lane >> 4;
    const int K = g.K, nth = K / BK, nt = Epi::HAS_MID ? 2 * nth : nth;
    int ts_lo = 0, ts_hi = 0, nts = 0; const unsigned long long rt_entry = STAMP ? (unsigned long long)wall_clock64() : 0ull;
#define PG8_STAMP() do { if (STAMP && wid == 0 && nts < 64) { const unsigned long long _c = (unsigned long long)clock64(); \
        ts_lo = (lane == nts) ? (int)(unsigned)_c : ts_lo; ts_hi = (lane == nts) ? (int)(unsigned)(_c >> 32) : ts_hi; ++nts; } } while (0)
    PG8_STAMP();
    unsigned voffA[2], voffB[2];
#pragma unroll
    for (int i = 0; i < 2; ++i) { int R, C; stage_rc(tid * 16 + i * 8192, R, C); const int Rb = Epi::PERM ? ((R & ~31) + perm32(R & 31)) : R;
        voffA[i] = (unsigned)(R * K + C) * 2u; voffB[i] = (unsigned)(Rb * K + C) * 2u; }
    const size_t kstep = (size_t)(BK * 2);
    const size_t hstep = (size_t)HALF * K * 2;
    const size_t tstep = 2 * hstep;
    const unsigned ldsw = (unsigned)wid * 1024u;
    const int aoff = lds_byte(wr * 64 + fr, fq * 8), boff = lds_byte(wc * 32 + fr, fq * 8);
#define PG8_SA(b, h) (((b) * 2 + (h)) * HTB)
#define PG8_SB(b, h) ((4 + (b) * 2 + (h)) * HTB)
#define PG8_STAGE(bufoff, gbase, voff) do { _Pragma("unroll") for (int _i = 0; _i < 2; ++_i) \
        __builtin_amdgcn_global_load_lds((const unsigned*)((const char*)(gbase) + (voff)[_i]), (PG8_LAS unsigned*)(lds + (bufoff) + ldsw + _i * 8192), 16, 0, 0); } while (0)
#define PG8_CAT8(lo, hi) __builtin_shufflevector(__builtin_bit_cast(i32x4, lo), __builtin_bit_cast(i32x4, hi), 0, 1, 2, 3, 4, 5, 6, 7)
#define PG8_LDA(dst, b, h) do { if constexpr (F8) { _Pragma("unroll") for (int m = 0; m < 4; ++m) dst##8[m] = PG8_CAT8(*(const PG8_LAS bf16x8*)(lds + PG8_SA(b, h) + aoff + m * 2048), *(const PG8_LAS bf16x8*)(lds + PG8_SA(b, h) + aoff + m * 2048 + 1024)); } \
        else { _Pragma("unroll") for (int m = 0; m < 4; ++m) _Pragma("unroll") for (int k = 0; k < 2; ++k) dst[m][k] = *(const PG8_LAS bf16x8*)(lds + PG8_SA(b, h) + aoff + m * 2048 + k * 1024); } } while (0)
#define PG8_LDB(dst, b, h) do { if constexpr (F8) { _Pragma("unroll") for (int n = 0; n < 2; ++n) dst##8[n] = PG8_CAT8(*(const PG8_LAS bf16x8*)(lds + PG8_SB(b, h) + boff + n * 2048), *(const PG8_LAS bf16x8*)(lds + PG8_SB(b, h) + boff + n * 2048 + 1024)); } \
        else { _Pragma("unroll") for (int n = 0; n < 2; ++n) _Pragma("unroll") for (int k = 0; k < 2; ++k) dst[n][k] = *(const PG8_LAS bf16x8*)(lds + PG8_SB(b, h) + boff + n * 2048 + k * 1024); } } while (0)
#define PG8_MMA(ai, bj, At, Bt) do { __builtin_amdgcn_s_setprio(1); \
        if constexpr (F8 && F6) { _Pragma("unroll") for (int m = 0; m < 4; ++m) _Pragma("unroll") for (int n = 0; n < 2; ++n) { \
            const i32x6 b6_ = __builtin_shufflevector(Bt##8[n], Bt##8[n], 0, 1, 2, 3, 4, 5), a6_ = __builtin_shufflevector(At##8[m], At##8[m], 0, 1, 2, 3, 4, 5); \
            asm volatile("s_nop 1\n\tv_mfma_scale_f32_16x16x128_f8f6f4 %0, %1, %2, %0, %3, %4 op_sel_hi:[0,0,0] cbsz:2 blgp:2" : "+v"(acc[ai][bj][m][n]) : "v"(b6_), "v"(a6_), "v"(Bt##8[n][6]), "v"(At##8[m][6])); } } \
        else if constexpr (F8) { _Pragma("unroll") for (int m = 0; m < 4; ++m) _Pragma("unroll") for (int n = 0; n < 2; ++n) \
            asm volatile("s_nop 1\n\tv_mfma_f32_16x16x128_f8f6f4 %0, %1, %2, %0" : "+v"(acc[ai][bj][m][n]) : "v"(Bt##8[n]), "v"(At##8[m])); }   \
        else { _Pragma("unroll") for (int m = 0; m < 4; ++m) _Pragma("unroll") for (int n = 0; n < 2; ++n) _Pragma("unroll") for (int k = 0; k < 2; ++k) \
            acc[ai][bj][m][n] = __builtin_amdgcn_mfma_f32_16x16x32_bf16(Bt[n][k], At[m][k], acc[ai][bj][m][n], 0, 0, 0); } \
        __builtin_amdgcn_s_setprio(0); } while (0)
#define PG8_WAIT_V(n) asm volatile("s_waitcnt vmcnt(" #n ")" ::: "memory")
#define PG8_WAIT_L(n) asm volatile("s_waitcnt lgkmcnt(" #n ")" ::: "memory")
#define PG8_BAR __builtin_amdgcn_s_barrier()
#define PG8_SCHED __builtin_amdgcn_sched_barrier(0)
    Unit cur, nxt; int ui = 0;
    if (!S.next(0, cur)) return;
    f32x4 acc[2][2][4][2];
#pragma unroll
    for (int a = 0; a < 2; ++a)
#pragma unroll
        for (int b = 0; b < 2; ++b)
#pragma unroll
            for (int m = 0; m < 4; ++m)
#pragma unroll
                for (int n = 0; n < 2; ++n) acc[a][b][m][n] = (f32x4){0.f, 0.f, 0.f, 0.f};
    bf16x8 At[4][2], B0[2][2], B1[2][2]; i32x8 At8[4], B08[2], B18[2];
    const char* cA = (const char*)g.A + (size_t)cur.pm * tstep; const char* cB = (const char*)g.Bt + (size_t)cur.pn * tstep;
    const char* cA2 = Epi::HAS_MID ? (const char*)g.A2 + (size_t)cur.pm * tstep : cA; const char* cB2 = Epi::HAS_MID ? (const char*)g.Bt2 + (size_t)cur.pn * tstep : cB;
#define PG8_TP(c1, c2, tt) ((Epi::HAS_MID && (tt) >= nth) ? (c2) + (size_t)((tt) - nth) * kstep : (c1) + (size_t)(tt) * kstep)
    S.a_ready(cur);
    PG8_STAGE(PG8_SB(0, 0), cB, voffB); PG8_STAGE(PG8_SA(0, 0), cA, voffA); PG8_STAGE(PG8_SB(0, 1), cB + hstep, voffB); PG8_STAGE(PG8_SA(0, 1), cA + hstep, voffA);
    if (wr == 1) PG8_BAR;
    PG8_WAIT_V(4); PG8_BAR;
    PG8_STAGE(PG8_SB(1, 0), cB + kstep, voffB); PG8_STAGE(PG8_SA(1, 0), cA + kstep, voffA); PG8_STAGE(PG8_SB(1, 1), cB + hstep + kstep, voffB);
    PG8_WAIT_V(6); PG8_BAR;
    PG8_STAMP();
    for (;;) {
        const bool has_next = S.next(ui + 1, nxt);
        const char* nA = has_next ? (const char*)g.A + (size_t)nxt.pm * tstep : cA; const char* nB = has_next ? (const char*)g.Bt + (size_t)nxt.pn * tstep : cB;
        for (int t = 0; t < nt; t += 2) {
            const bool last = (t == nt - 2);
            const char* a1 = PG8_TP(cA, cA2, t + 1);
            const char* a2 = last ? nA : PG8_TP(cA, cA2, t + 2); const char* b2 = last ? nB : PG8_TP(cB, cB2, t + 2);
            if constexpr (Epi::HAS_MID) { if (t == nth) { if constexpr (F8) asm volatile("s_nop 15" ::: "memory"); E.mid(acc, cur, wr, wc, fr, fq); } }
            const char* a3 = a2 + kstep; const char* b3 = b2 + kstep;
            if (last && has_next) S.a_ready(nxt);
            PG8_LDB(B0, 0, 0); PG8_SCHED; PG8_LDA(At, 0, 0); PG8_STAGE(PG8_SA(1, 1), a1 + hstep, voffA);
            PG8_WAIT_L(8); PG8_BAR; PG8_WAIT_L(0); PG8_MMA(0, 0, At, B0); PG8_BAR; PG8_SCHED;
            PG8_LDB(B1, 0, 1); PG8_STAGE(PG8_SB(0, 0), b2, voffB);
            PG8_BAR; PG8_WAIT_L(0); PG8_MMA(0, 1, At, B1); PG8_BAR;
            PG8_LDA(At, 0, 1); PG8_STAGE(PG8_SA(0, 0), a2, voffA);
            PG8_BAR; PG8_WAIT_L(0); PG8_MMA(1, 0, At, B0); PG8_BAR; PG8_SCHED;
            PG8_STAGE(PG8_SB(0, 1), b2 + hstep, voffB);
            PG8_WAIT_V(6); PG8_BAR; PG8_MMA(1, 1, At, B1); PG8_BAR;
            PG8_LDB(B0, 1, 0); PG8_SCHED; PG8_LDA(At, 1, 0); PG8_STAGE(PG8_SA(0, 1), a2 + hstep, voffA);
            PG8_WAIT_L(8); PG8_BAR; PG8_WAIT_L(0); PG8_MMA(0, 0, At, B0); PG8_BAR; PG8_SCHED;
            PG8_LDB(B1, 1, 1); PG8_STAGE(PG8_SB(1, 0), b3, voffB);
            PG8_BAR; PG8_WAIT_L(0); PG8_MMA(0, 1, At, B1); PG8_BAR;
            PG8_LDA(At, 1, 1); PG8_STAGE(PG8_SA(1, 0), a3, voffA);
            PG8_BAR; PG8_WAIT_L(0); PG8_MMA(1, 0, At, B0); PG8_BAR; PG8_SCHED;
            PG8_STAGE(PG8_SB(1, 1), b3 + hstep, voffB);
            PG8_WAIT_V(6); PG8_BAR; PG8_MMA(1, 1, At, B1); PG8_BAR;
        }
        PG8_STAMP();
        if constexpr (F8) asm volatile("s_nop 15" ::: "memory");
        if constexpr (!Epi::AFTER_DRAIN) { E(acc, cur, wr, wc, fr, fq); S.done(cur); }
        PG8_STAMP();
        if (!has_next) break;
#pragma unroll
        for (int a = 0; a < 2; ++a)
#pragma unroll
            for (int b = 0; b < 2; ++b)
#pragma unroll
                for (int m = 0; m < 4; ++m)
#pragma unroll
                    for (int n = 0; n < 2; ++n) acc[a][b][m][n] = (f32x4){0.f, 0.f, 0.f, 0.f};
        cur = nxt; cA = nA; cB = nB; ++ui;
        if constexpr (Epi::HAS_MID) { cA2 = (const char*)g.A2 + (size_t)cur.pm * tstep; cB2 = (const char*)g.Bt2 + (size_t)cur.pn * tstep; }
    }
    PG8_WAIT_V(0);
    if (wr == 0) PG8_BAR;
    PG8_BAR;
    if constexpr (Epi::AFTER_DRAIN) { E.fused(acc, cur, wr, wc, fr, fq, lds, wid, lane); S.done(cur); }
    PG8_STAMP();
    if (STAMP && wid == 0) { stamps[lane] = lane < nts ? (((unsigned long long)(unsigned)ts_hi << 32) | (unsigned)ts_lo) : 0ull;
        if (lane == 62) stamps[62] = rt_entry; if (lane == 63) stamps[63] = (unsigned long long)wall_clock64(); }
#undef PG8_STAMP
#undef PG8_TP
#undef PG8_SA
#undef PG8_SB
#undef PG8_STAGE
#undef PG8_LDA
#undef PG8_LDB
#undef PG8_MMA
#undef PG8_CAT8
#undef PG8_WAIT_V
#undef PG8_WAIT_L
#undef PG8_BAR
#undef PG8_SCHED
}
}

constexpr int T = 16384, D = 2048, SEQ = 4096, NB = 4;
constexpr int NIN = 15360, WIN_LD = 15376;
constexpr float EPS = 1e-6f;
constexpr int NWAVES = 8, NTHR = 512;
constexpr int NPHASE = 11;
constexpr size_t MiB = 1u << 20;
#ifndef IN16_COLS
#define IN16_COLS 0
#endif
constexpr size_t WS_CTL = 0, CTL_ZERO_BYTES = 64 * 1024;
constexpr size_t WS_GATES = 1 * MiB;
constexpr size_t WS_U = 2 * MiB, WS_MX = WS_U + 512 * 1024, WS_WI = WS_MX + 512 * 1024, WS_WK = WS_WI + 512 * 1024, WS_MR = WS_WK + 512 * 1024, WS_DEN = WS_MR + 512 * 1024, WS_DEC = WS_DEN + 512 * 1024;
constexpr size_t WS_B4G = 6 * MiB;
constexpr size_t WS_XN = 8 * MiB;
constexpr size_t WS_Q = 72 * MiB;
constexpr size_t WS_K = 136 * MiB;
constexpr size_t WS_AQ = 200 * MiB;
constexpr size_t WS_KT = 264 * MiB;
constexpr size_t WS_VT = 328 * MiB;
constexpr size_t WS_SO = 392 * MiB;
constexpr size_t WS_AK = 456 * MiB, WS_AV = 472 * MiB;
constexpr size_t WS_WIN16 = 488 * MiB;
constexpr size_t WS_WIN8 = (IN16_COLS == 0 ? 488 : 504) * MiB;
constexpr size_t WS_XN8 = 530 * MiB;
constexpr size_t WS_SS = 488 * MiB;
constexpr size_t WS_EXP = 488 * MiB, WS_GATE = 496 * MiB;
constexpr size_t WS_WA = 504 * MiB, WS_WM = 512 * MiB, WS_WO = 520 * MiB, WS_WQ = 528 * MiB;
constexpr size_t WS_KEYS = 536 * MiB;
constexpr size_t WS_AC = 540 * MiB, WS_NC = 544 * MiB;
constexpr size_t WS_END = 562 * MiB;
#ifndef IN_FP6
#define IN_FP6 1
#endif
#ifndef P6_FP8
#define P6_FP8 1
#endif
constexpr int N16 = IN16_COLS;
constexpr float XN8_SCALE = 8.0f, WIN8_SCALE = 256.0f, H8_SCALE = 8.0f;
constexpr size_t WS_X1 = WS_AQ;
constexpr size_t WS_HA8 = WS_XN, WS_HM8 = WS_KT + 32 * MiB;
constexpr int CW_BAR = 4096;

constexpr int LDS_BYTES = 163840;
constexpr int MISC_OFF = LDS_BYTES - 256;

#define GAS __attribute__((address_space(1)))
#define LAS __attribute__((address_space(3)))
typedef unsigned short bf16_t;
typedef float f32x4 __attribute__((ext_vector_type(4)));
typedef float f32x16 __attribute__((ext_vector_type(16)));
typedef float f32x2v __attribute__((ext_vector_type(2)));
typedef short bf16x8 __attribute__((ext_vector_type(8)));
typedef short s16x4 __attribute__((ext_vector_type(4)));
typedef unsigned u32x4 __attribute__((ext_vector_type(4)));
typedef unsigned u32x2 __attribute__((ext_vector_type(2)));
typedef __bf16 bf2_t __attribute__((ext_vector_type(2)));

__device__ __forceinline__ unsigned f2bf(float f) { return (unsigned)__builtin_bit_cast(unsigned short, (__bf16)f); }
__device__ __forceinline__ unsigned cvtpk(float lo, float hi) { bf2_t v; v[0] = (__bf16)lo; v[1] = (__bf16)hi; return __builtin_bit_cast(unsigned, v); }
__device__ __forceinline__ unsigned pk2(float lo, float hi) { return cvtpk(lo, hi); }
__device__ __forceinline__ float bflo(unsigned u) { return __uint_as_float(u << 16); }
__device__ __forceinline__ float bfhi(unsigned u) { return __uint_as_float(u & 0xffff0000u); }
__device__ __forceinline__ float wave_sum(float v) {
#pragma unroll
    for (int o = 1; o < 64; o <<= 1) v += __shfl_xor(v, o);
    return v;
}
__device__ __forceinline__ float sigmoidf_(float x) { return __builtin_amdgcn_rcpf(1.0f + __expf(-x)); }
__device__ __forceinline__ bf16x8 pack8(const f32x4 a, const f32x4 b) {
    u32x4 w; w.x = cvtpk(a[0], a[1]); w.y = cvtpk(a[2], a[3]); w.z = cvtpk(b[0], b[1]); w.w = cvtpk(b[2], b[3]);
    return __builtin_bit_cast(bf16x8, w);
}
#define MFMA16(a, b, c) __builtin_amdgcn_mfma_f32_16x16x32_bf16((a), (b), (c), 0, 0, 0)
#define GLDS16(gptr, ldsptr) __builtin_amdgcn_global_load_lds((const unsigned*)(gptr), (LAS unsigned*)(ldsptr), 16, 0, 0)
#define GLDS4(gptr, ldsptr) __builtin_amdgcn_global_load_lds((const unsigned*)(gptr), (LAS unsigned*)(ldsptr), 4, 0, 0)
#define VM_WAIT() asm volatile("s_waitcnt vmcnt(0)" ::: "memory")

#define XB_TMO      128
#define XB_XCNT(j)  (256  + 64 * (j))
#define XB_XSUB(j)  (1280 + 64 * (j))
#define XB_XGEN(j)  (2304 + 64 * (j))
#define XB_TOP      3328
#define XB_TOPGEN   3392
#define XCD_BAR_WORDS 3456
#define XB_SPIN_CAP (1u << 18)

__device__ __forceinline__ unsigned xb_ld(unsigned* p)              { return __hip_atomic_load(p, __ATOMIC_RELAXED, __HIP_MEMORY_SCOPE_AGENT); }
__device__ __forceinline__ unsigned xb_add(unsigned* p, unsigned v) { return __hip_atomic_fetch_add(p, v, __ATOMIC_RELAXED, __HIP_MEMORY_SCOPE_AGENT); }
__device__ __forceinline__ unsigned xb_xcc_id() { return (unsigned)__builtin_amdgcn_s_getreg((3 << 11) | 20) & 0xFu; }
#define XB_SPIN(cond, bar) do { unsigned _sp = 0; while (cond) { __builtin_amdgcn_s_sleep(1); \
    if ((++_sp & 255u) == 0u) { if (xb_ld(&(bar)[XB_TMO])) break; if (_sp > XB_SPIN_CAP) { atomicAdd(&(bar)[XB_TMO], 1u); break; } } } } while (0)

struct XcdBarrier {
    unsigned* bar; unsigned x;
    volatile LAS unsigned* st;
};

__device__ __forceinline__ XcdBarrier xcd_barrier_post(unsigned* bar, volatile LAS unsigned* st) {
    XcdBarrier b; b.bar = bar; b.x = xb_xcc_id(); b.st = st;
    if (threadIdx.x == 0) (void)xb_add(&bar[XB_XCNT(b.x)], 1u);
    return b;
}
__device__ __forceinline__ void xcd_barrier_complete(unsigned* bar, unsigned x, unsigned& nloc, unsigned& nx) {
    const unsigned G = gridDim.x * gridDim.y * gridDim.z;
    unsigned sum, cnt, mine, sp = 0u;
    for (;;) {
        sum = 0u; cnt = 0u; mine = 0u;
#pragma unroll
        for (unsigned j = 0; j < 16; ++j) { const unsigned c = xb_ld(&bar[XB_XCNT(j)]); sum += c; cnt += (c > 0u) ? 1u : 0u; mine = (j == x) ? c : mine; }
        if (sum == G) break;
        __builtin_amdgcn_s_sleep(1);
        if ((++sp & 255u) == 0u) { if (xb_ld(&bar[XB_TMO])) break; if (sp > XB_SPIN_CAP) { atomicAdd(&bar[XB_TMO], 1u); break; } }
    }
    nloc = mine > 0u ? mine : 1u; nx = cnt > 0u ? cnt : 1u;
}

__device__ __forceinline__ void xcd_barrier(const XcdBarrier& b) {
    asm volatile("s_waitcnt vmcnt(0)" ::: "memory");
    __syncthreads();
    if (threadIdx.x == 0) {
        unsigned* bar = b.bar;
        __builtin_amdgcn_s_waitcnt(0);
        unsigned nloc = b.st[0], nx = b.st[1];
        if (nloc == 0u) { xcd_barrier_complete(bar, b.x, nloc, nx); b.st[0] = nloc; b.st[1] = nx; }
        const unsigned old = xb_add(&bar[XB_XSUB(b.x)], 1u);
        const unsigned gen = old / nloc;
        if (old + 1u == (gen + 1u) * nloc) {
            __builtin_amdgcn_fence(__ATOMIC_RELEASE, "agent");
            asm volatile("s_waitcnt vmcnt(0)" ::: "memory");
            const unsigned og = xb_add(&bar[XB_TOP], 1u);
            const unsigned tg = og / nx;
            if (og + 1u == (tg + 1u) * nx) xb_add(&bar[XB_TOPGEN], 1u);
            else XB_SPIN(xb_ld(&bar[XB_TOPGEN]) == tg, bar);
            __builtin_amdgcn_fence(__ATOMIC_ACQUIRE, "agent");
            xb_add(&bar[XB_XGEN(b.x)], 1u);
            asm volatile("s_waitcnt vmcnt(0)" ::: "memory");
        } else {
            XB_SPIN(xb_ld(&bar[XB_XGEN(b.x)]) == gen, bar);
            __builtin_amdgcn_fence(__ATOMIC_ACQUIRE, "agent");
            asm volatile("s_waitcnt vmcnt(0)" ::: "memory");
        }
    }
    __syncthreads();
}

struct EpiInProj {
    static constexpr bool PERM = true, AFTER_DRAIN = false, HAS_MID = false;
    unsigned char* ws; bf16_t* GM;
    template <int ACT>
    __device__ __forceinline__ void rows(const f32x4 (&acc)[2][2][4][2], bf16_t* dst, int ldc, int colt, float scale, int row0, int wc, int fq) const {
#pragma unroll
        for (int ai = 0; ai < 2; ++ai)
#pragma unroll
            for (int m = 0; m < 4; ++m) { bf16_t* rowp = dst + (size_t)(row0 + ai * 128 + m * 16) * ldc + colt + wc * 32 + 8 * fq;
#pragma unroll
                for (int bj = 0; bj < 2; ++bj) { f32x4 v0 = acc[ai][bj][m][0], v1 = acc[ai][bj][m][1];
                    if (ACT == 1) {
#pragma unroll
                        for (int j = 0; j < 4; ++j) { v0[j] = sigmoidf_(v0[j] * scale); v1[j] = sigmoidf_(v1[j] * scale); } }
                    else { v0 = v0 * scale; v1 = v1 * scale; }
                    u32x4 w; w.x = cvtpk(v0[0], v0[1]); w.y = cvtpk(v0[2], v0[3]); w.z = cvtpk(v1[0], v1[1]); w.w = cvtpk(v1[2], v1[3]);
                    *(u32x4*)(rowp + bj * 128) = w; } }
    }
    __device__ __forceinline__ void rowsTiled(const f32x4 (&acc)[2][2][4][2], bf16_t* dst, int pm, int pnl, float scale, int row0, int wc, int fq) const {
        const int fr = row0 & 15, wr = (row0 >> 6) & 1;
        unsigned char* base = (unsigned char*)dst + ((size_t)((pm * 8 + pnl) * 8 + wr * 4 + wc)) * 16384 + (fq * 16 + fr) * 16;
#pragma unroll
        for (int ai = 0; ai < 2; ++ai)
#pragma unroll
            for (int bj = 0; bj < 2; ++bj)
#pragma unroll
                for (int m = 0; m < 4; ++m) { f32x4 v0 = acc[ai][bj][m][0], v1 = acc[ai][bj][m][1];
#pragma unroll
                    for (int j = 0; j < 4; ++j) { v0[j] = sigmoidf_(v0[j] * scale); v1[j] = sigmoidf_(v1[j] * scale); }
                    u32x4 w; w.x = cvtpk(v0[0], v0[1]); w.y = cvtpk(v0[2], v0[3]); w.z = cvtpk(v1[0], v1[1]); w.w = cvtpk(v1[2], v1[3]);
                    *(u32x4*)(base + ((ai * 2 + bj) * 4 + m) * 1024) = w; }
    }
    __device__ __forceinline__ void rowsT(const f32x4 (&acc)[2][2][4][2], bf16_t* dst, int colt, float scale, int row0, int wc, int fq) const {
        const int head = colt >> 9, d0 = (colt & 511) + wc * 32 + 8 * fq;
#pragma unroll
        for (int ai = 0; ai < 2; ++ai)
#pragma unroll
            for (int m = 0; m < 4; ++m) { const int r = row0 + ai * 128 + m * 16, b = r >> 12, s = r & 4095, chunk = s >> 6, j = s & 63;
                bf16_t* base = dst + ((size_t)((b * 4 + head) * 64 + chunk) * 512) * 64 + j;
#pragma unroll
                for (int bj = 0; bj < 2; ++bj)
#pragma unroll
                    for (int n = 0; n < 2; ++n)
#pragma unroll
                        for (int e = 0; e < 4; ++e) base[(size_t)(d0 + bj * 128 + 4 * n + e) * 64] = (bf16_t)f2bf(acc[ai][bj][m][n][e] * scale); }
    }
    int pn0; float osc;
    __device__ __forceinline__ void operator()(const f32x4 (&acc)[2][2][4][2], const pg8::Unit& u, int wr, int wc, int fr, int fq) const {
        const int pn = u.pn + pn0; int row0 = u.pm * 256 + wr * 64 + fr;
        asm volatile("" : "+v"(row0), "+v"(fq));
        bf16_t *Q = (bf16_t*)(ws + WS_Q), *K = (bf16_t*)(ws + WS_K), *KT = (bf16_t*)(ws + WS_KT), *VT = (bf16_t*)(ws + WS_VT), *SO = (bf16_t*)(ws + WS_SO), *AQ = (bf16_t*)(ws + WS_AQ), *AK = (bf16_t*)(ws + WS_AK), *AV = (bf16_t*)(ws + WS_AV);
        bf16_t* GA = GM + (size_t)T * D;
        if (pn < 8) rows<0>(acc, Q, D, pn * 256, osc, row0, wc, fq);
        else if (pn < 16) { rows<0>(acc, K, D, (pn - 8) * 256, 0.04419417382415922f * osc, row0, wc, fq); rowsT(acc, KT, (pn - 8) * 256, 0.04419417382415922f * osc, row0, wc, fq); }
        else if (pn < 24) rowsT(acc, VT, (pn - 16) * 256, osc, row0, wc, fq);
        else if (pn < 32) rows<1>(acc, SO, D, (pn - 24) * 256, osc, row0, wc, fq);
        else if (pn < 40) rows<0>(acc, AQ, D, (pn - 32) * 256, osc, row0, wc, fq);
        else if (pn < 42) rows<0>(acc, AK, 512, (pn - 40) * 256, osc, row0, wc, fq);
        else if (pn < 44) rows<0>(acc, AV, 512, (pn - 42) * 256, osc, row0, wc, fq);
        else if (pn < 52) rowsTiled(acc, GM, u.pm, pn - 44, osc, row0, wc, fq);
        else rowsTiled(acc, GA, u.pm, pn - 52, osc, row0, wc, fq);
    }
};
struct EpiMerge2 {
    static constexpr bool PERM = true, AFTER_DRAIN = false, HAS_MID = true;
    const bf16_t *GA, *GM; bf16_t* OUT; float osc;
    __device__ __forceinline__ void mid(f32x4 (&acc)[2][2][4][2], const pg8::Unit& u, int wr, int wc, int fr, int fq) const {
        int row0 = u.pm * 256 + wr * 64 + fr, col0 = u.pn * 256 + wc * 32 + 8 * fq;
        asm volatile("" : "+v"(row0), "+v"(col0));
        size_t tb0 = ((size_t)((u.pm * 8 + u.pn) * 8 + wr * 4 + wc)) * 16384 + (size_t)(fq * 16 + fr) * 16;
        asm volatile("" : "+v"(tb0));
        u32x4 ga[2][2], gm[2][2];
#define EM2_LOAD(g) do { const size_t toff = tb0 + (size_t)((((g) >> 2) * 2) * 4 + ((g) & 3)) * 1024;   \
            _Pragma("unroll") for (int bj = 0; bj < 2; ++bj) { ga[(g) & 1][bj] = *(const u32x4*)((const unsigned char*)GA + toff + bj * 4096); gm[(g) & 1][bj] = *(const u32x4*)((const unsigned char*)GM + toff + bj * 4096); } } while (0)
        EM2_LOAD(0);
#pragma unroll
        for (int g = 0; g < 8; ++g) { const int ai = g >> 2, m = g & 3;
            if (g + 1 < 8) EM2_LOAD(g + 1);
#pragma unroll
            for (int bj = 0; bj < 2; ++bj) { const u32x4 a = ga[g & 1][bj], q = gm[g & 1][bj];
                f32x4 r0, r1;
                r0[0] = bflo(a.x) * __builtin_amdgcn_rcpf(fmaxf(bflo(q.x), 1e-20f)); r0[1] = bfhi(a.x) * __builtin_amdgcn_rcpf(fmaxf(bfhi(q.x), 1e-20f));
                r0[2] = bflo(a.y) * __builtin_amdgcn_rcpf(fmaxf(bflo(q.y), 1e-20f)); r0[3] = bfhi(a.y) * __builtin_amdgcn_rcpf(fmaxf(bfhi(q.y), 1e-20f));
                r1[0] = bflo(a.z) * __builtin_amdgcn_rcpf(fmaxf(bflo(q.z), 1e-20f)); r1[1] = bfhi(a.z) * __builtin_amdgcn_rcpf(fmaxf(bfhi(q.z), 1e-20f));
                r1[2] = bflo(a.w) * __builtin_amdgcn_rcpf(fmaxf(bflo(q.w), 1e-20f)); r1[3] = bfhi(a.w) * __builtin_amdgcn_rcpf(fmaxf(bfhi(q.w), 1e-20f));
                acc[ai][bj][m][0] = acc[ai][bj][m][0] * r0; acc[ai][bj][m][1] = acc[ai][bj][m][1] * r1; }
            asm volatile("" ::: "memory"); }
#undef EM2_LOAD
    }
    __device__ __forceinline__ void operator()(const f32x4 (&acc)[2][2][4][2], const pg8::Unit& u, int wr, int wc, int fr, int fq) const {
        int row0 = u.pm * 256 + wr * 64 + fr, col0 = u.pn * 256 + wc * 32 + 8 * fq;
        size_t tb0 = ((size_t)((u.pm * 8 + u.pn) * 8 + wr * 4 + wc)) * 16384 + (size_t)(fq * 16 + fr) * 16;
        asm volatile("" : "+v"(row0), "+v"(col0), "+v"(tb0));
#pragma unroll
        for (int ai = 0; ai < 2; ++ai) { u32x4 gg[4][2];
#pragma unroll
            for (int m = 0; m < 4; ++m)
#pragma unroll
                for (int bj = 0; bj < 2; ++bj) gg[m][bj] = *(const u32x4*)((const unsigned char*)GM + tb0 + (size_t)((ai * 2 + bj) * 4 + m) * 1024);
#pragma unroll
            for (int m = 0; m < 4; ++m) { const size_t off = (size_t)(row0 + ai * 128 + m * 16) * D + col0;
#pragma unroll
                for (int bj = 0; bj < 2; ++bj) { const u32x4 g = gg[m][bj];
                    f32x4 o0, o1; o0[0] = bflo(g.x); o0[1] = bfhi(g.x); o0[2] = bflo(g.y); o0[3] = bfhi(g.y); o1[0] = bflo(g.z); o1[1] = bfhi(g.z); o1[2] = bflo(g.w); o1[3] = bfhi(g.w);
                    o0 = o0 * acc[ai][bj][m][0] * osc; o1 = o1 * acc[ai][bj][m][1] * osc;
#if P6_FP8
                    int p0 = 0, p1 = 0;
                    p0 = __builtin_amdgcn_cvt_pk_fp8_f32(o0[0], o0[1], p0, false); p0 = __builtin_amdgcn_cvt_pk_fp8_f32(o0[2], o0[3], p0, true);
                    p1 = __builtin_amdgcn_cvt_pk_fp8_f32(o1[0], o1[1], p1, false); p1 = __builtin_amdgcn_cvt_pk_fp8_f32(o1[2], o1[3], p1, true);
                    u32x2 w; w.x = (unsigned)p0; w.y = (unsigned)p1;
                    *(u32x2*)((unsigned char*)OUT + off + bj * 128) = w; } } }
#else
                    u32x4 w; w.x = cvtpk(o0[0], o0[1]); w.y = cvtpk(o0[2], o0[3]); w.z = cvtpk(o1[0], o1[1]); w.w = cvtpk(o1[2], o1[3]);
                    *(u32x4*)(OUT + off + bj * 128) = w; } } }
#endif
    }
};
struct EpiResid {
    static constexpr bool PERM = false, AFTER_DRAIN = false, HAS_MID = false;
    const float* BASE; bf16_t* OUT; float osc;
    __device__ __forceinline__ void operator()(const f32x4 (&acc)[2][2][4][2], const pg8::Unit& u, int wr, int wc, int fr, int fq) const {
        const int row0 = u.pm * 256 + wr * 64 + fr, col0 = u.pn * 256 + wc * 32 + 4 * fq;
#pragma unroll
        for (int ai = 0; ai < 2; ++ai)
#pragma unroll
            for (int mh = 0; mh < 2; ++mh) { f32x4 xb[2][2][2];
#pragma unroll
                for (int mm = 0; mm < 2; ++mm) { const size_t off = (size_t)(row0 + ai * 128 + (2 * mh + mm) * 16) * D + col0;
#pragma unroll
                    for (int bj = 0; bj < 2; ++bj)
#pragma unroll
                        for (int n = 0; n < 2; ++n) xb[mm][bj][n] = *(const f32x4*)(BASE + off + bj * 128 + n * 16); }
#pragma unroll
                for (int mm = 0; mm < 2; ++mm) { const size_t off = (size_t)(row0 + ai * 128 + (2 * mh + mm) * 16) * D + col0;
#pragma unroll
                    for (int bj = 0; bj < 2; ++bj)
#pragma unroll
                        for (int n = 0; n < 2; ++n) { const f32x4 o = xb[mm][bj][n] + acc[ai][bj][2 * mh + mm][n] * osc; u32x2 w; w.x = cvtpk(o[0], o[1]); w.y = cvtpk(o[2], o[3]); *(u32x2*)(OUT + off + bj * 128 + n * 16) = w; } } }
    }
};
struct EpiPlainBf16 {
    static constexpr bool PERM = true, AFTER_DRAIN = false, HAS_MID = false;
    bf16_t* OUT;
    __device__ __forceinline__ void operator()(const f32x4 (&acc)[2][2][4][2], const pg8::Unit& u, int wr, int wc, int fr, int fq) const {
        const int row0 = u.pm * 256 + wr * 64 + fr, col0 = u.pn * 256 + wc * 32 + 8 * fq;
#pragma unroll
        for (int ai = 0; ai < 2; ++ai)
#pragma unroll
            for (int m = 0; m < 4; ++m) { const int t = row0 + ai * 128 + m * 16;
#pragma unroll
                for (int bj = 0; bj < 2; ++bj) { const f32x4 v0 = acc[ai][bj][m][0], v1 = acc[ai][bj][m][1];
                    u32x4 w; w.x = cvtpk(v0[0], v0[1]); w.y = cvtpk(v0[2], v0[3]); w.z = cvtpk(v1[0], v1[1]); w.w = cvtpk(v1[2], v1[3]);
                    const int c = col0 + bj * 128;
                    *(u32x4*)((unsigned char*)OUT + ((size_t)((((t >> 5) * 8 + (c >> 8)) * 2 + ((c >> 7) & 1)) * 8 + ((c >> 4) & 7))) * 1024 + (((c >> 3) & 1) * 32 + (t & 31)) * 16) = w; } }
    }
};

struct Args {
    const float *x, *norm1_g, *w_in, *gate_b, *mnorm_g, *w_m, *gq, *gk, *sink, *rel_bias, *w_a, *w_out, *norm2_g, *peer_wq, *peer_keys, *peer_u, *peer_v;
    float* out; unsigned char* ws; int ph_lo, ph_hi;
};

typedef unsigned u32x6 __attribute__((ext_vector_type(6)));
typedef float f32x16v __attribute__((ext_vector_type(16)));
typedef float f32x32v __attribute__((ext_vector_type(32)));
__device__ __forceinline__ unsigned enc_e2m3(float y) {
    const float a = __builtin_fabsf(y);
    const float mul = a < 2.f ? 8.f : (a < 4.f ? 4.f : 2.f), off = a < 2.f ? 0.f : (a < 4.f ? 8.f : 16.f);
    const float c = __builtin_rintf(a * mul) + off;
    unsigned u = (unsigned)c; u = u > 31u ? 31u : u;
    return u | ((__float_as_uint(y) >> 26) & 32u);
}
__device__ __forceinline__ unsigned fp6_block_exp(float am) {
    const unsigned tb = __float_as_uint(am * (1.0f / 7.5f));
    unsigned E = ((tb >> 23) & 255u) + ((tb & 0x7fffffu) ? 1u : 0u); return E < 1u ? 1u : (E > 253u ? 253u : E);
}
__device__ __forceinline__ unsigned enc4_e2m3(float a, float b, float c, float d, float sc) { return enc_e2m3(a * sc) | (enc_e2m3(b * sc) << 6) | (enc_e2m3(c * sc) << 12) | (enc_e2m3(d * sc) << 18); }
__device__ __forceinline__ void pack_fp6_slot(const float (&v)[32], unsigned char* dst) {
    float am = 0.f;
#pragma unroll
    for (int i = 0; i < 32; ++i) am = __builtin_fmaxf(am, __builtin_fabsf(v[i]));
    const unsigned E = fp6_block_exp(am); const float sc = __uint_as_float((254u - E) << 23);
    unsigned c[8];
#pragma unroll
    for (int i = 0; i < 8; ++i) c[i] = enc4_e2m3(v[4 * i], v[4 * i + 1], v[4 * i + 2], v[4 * i + 3], sc);
    *(u32x4*)dst = (u32x4){c[0] | (c[1] << 24), (c[1] >> 8) | (c[2] << 16), (c[2] >> 16) | (c[3] << 8), c[4] | (c[5] << 24)};
    *(u32x4*)(dst + 64) = (u32x4){(c[5] >> 8) | (c[6] << 16), (c[6] >> 16) | (c[7] << 8), E * 0x01010101u, 0u};
}
__device__ __forceinline__ void pack_fp6_slot8(const f32x4 (&t)[8], unsigned char* dst) {
    f32x4 m4 = __builtin_elementwise_max(__builtin_elementwise_abs(t[0]), __builtin_elementwise_abs(t[1]));
#pragma unroll
    for (int i = 2; i < 8; ++i) m4 = __builtin_elementwise_max(m4, __builtin_elementwise_abs(t[i]));
    const float am = __builtin_fmaxf(__builtin_fmaxf(m4[0], m4[1]), __builtin_fmaxf(m4[2], m4[3]));
    const unsigned tb = __float_as_uint(am * (1.0f / 7.5f));
    unsigned E = ((tb >> 23) & 255u) + ((tb & 0x7fffffu) ? 1u : 0u); E = E < 1u ? 1u : (E > 254u ? 254u : E);
    typedef float f32x8v __attribute__((ext_vector_type(8)));
    const f32x8v a01 = __builtin_shufflevector(t[0], t[1], 0, 1, 2, 3, 4, 5, 6, 7), a23 = __builtin_shufflevector(t[2], t[3], 0, 1, 2, 3, 4, 5, 6, 7);
    const f32x8v b01 = __builtin_shufflevector(t[4], t[5], 0, 1, 2, 3, 4, 5, 6, 7), b23 = __builtin_shufflevector(t[6], t[7], 0, 1, 2, 3, 4, 5, 6, 7);
    const f32x16v a = __builtin_shufflevector(a01, a23, 0, 1, 2, 3, 4, 5, 6, 7, 8, 9, 10, 11, 12, 13, 14, 15), b = __builtin_shufflevector(b01, b23, 0, 1, 2, 3, 4, 5, 6, 7, 8, 9, 10, 11, 12, 13, 14, 15);
    const u32x6 q = __builtin_amdgcn_cvt_scalef32_2xpk16_fp6_f32(a, b, __uint_as_float(E << 23));
    *(u32x4*)dst = (u32x4){q[0], q[1], q[2], q[3]}; *(u32x4*)(dst + 16) = (u32x4){q[4], q[5], E * 0x01010101u, 0u};
}
__device__ __forceinline__ void transpose_item(const float* W, int ldw, int K, int nblk, bf16_t* WT, LAS float* scr, int item, int lane, bool skip16, const float* ksc = nullptr) {
    const int kb = item / nblk, nb = item % nblk, k0 = 64 * kb, n0 = 32 * nb, ns = n0 + ((skip16 && n0 >= 8192) ? 16 : 0);
    if (ksc) {
#pragma unroll
        for (int i = 0; i < 32; ++i) { const int kk = 2 * i + (lane >> 5); scr[kk * 33 + (lane & 31)] = W[(size_t)(k0 + kk) * ldw + ns + (lane & 31)] * ksc[k0 + kk]; } }
    else {
#pragma unroll
    for (int i = 0; i < 32; ++i) { const int kk = 2 * i + (lane >> 5); scr[kk * 33 + (lane & 31)] = W[(size_t)(k0 + kk) * ldw + ns + (lane & 31)]; } }
    asm volatile("s_waitcnt lgkmcnt(0)" ::: "memory");
    const int c = lane & 7;
#pragma unroll
    for (int j = 0; j < 4; ++j) { const int n = (lane >> 3) + 8 * j; const LAS float* s = scr + (8 * c) * 33 + n;
        u32x4 o; o.x = pk2(s[0 * 33], s[1 * 33]); o.y = pk2(s[2 * 33], s[3 * 33]); o.z = pk2(s[4 * 33], s[5 * 33]); o.w = pk2(s[6 * 33], s[7 * 33]);
        *(u32x4*)(WT + (size_t)(n0 + n) * K + k0 + 8 * c) = o; }
    asm volatile("s_waitcnt lgkmcnt(0)" ::: "memory");
}
template <bool INPROJ> __device__ __forceinline__ void transpose_item8(const float* W, int ldw, int K, int nblk, unsigned char* WT8, LAS float* scr, int item, int lane) {
    const int kb = item / nblk, nb = item % nblk, k0 = 64 * kb, n0 = 32 * nb, ns = n0 + ((INPROJ && n0 >= 8192) ? 16 : 0), nd = INPROJ ? n0 - N16 : n0;
#pragma unroll
    for (int i = 0; i < 32; ++i) { const int kk = 2 * i + (lane >> 5); scr[kk * 33 + (lane & 31)] = W[(size_t)(k0 + kk) * ldw + ns + (lane & 31)]; }
    asm volatile("s_waitcnt lgkmcnt(0)" ::: "memory");
    const int c = lane & 7;
#pragma unroll
    for (int j = 0; j < 4; ++j) { const int n = (lane >> 3) + 8 * j; const LAS float* s = scr + (8 * c) * 33 + n;
        int p0 = 0, p1 = 0;
        p0 = __builtin_amdgcn_cvt_pk_fp8_f32(s[0 * 33] * WIN8_SCALE, s[1 * 33] * WIN8_SCALE, p0, false); p0 = __builtin_amdgcn_cvt_pk_fp8_f32(s[2 * 33] * WIN8_SCALE, s[3 * 33] * WIN8_SCALE, p0, true);
        p1 = __builtin_amdgcn_cvt_pk_fp8_f32(s[4 * 33] * WIN8_SCALE, s[5 * 33] * WIN8_SCALE, p1, false); p1 = __builtin_amdgcn_cvt_pk_fp8_f32(s[6 * 33] * WIN8_SCALE, s[7 * 33] * WIN8_SCALE, p1, true);
        u32x2 o; o.x = (unsigned)p0; o.y = (unsigned)p1;
        *(u32x2*)(WT8 + (size_t)(nd + n) * K + k0 + 8 * c) = o; }
    asm volatile("s_waitcnt lgkmcnt(0)" ::: "memory");
}
template <bool INPROJ> __device__ __forceinline__ void transpose_item6(const float* W, int ldw, int K, int nblk, unsigned char* WT6, LAS float* scr, int item, int lane) {
    const int kb = item / nblk, nb = item % nblk, k0 = 64 * kb, n0 = 32 * nb, ns = n0 + ((INPROJ && n0 >= 8192) ? 16 : 0), nd = INPROJ ? n0 - N16 : n0;
#pragma unroll
    for (int i = 0; i < 32; ++i) { const int kk = 2 * i + (lane >> 5); scr[kk * 33 + (lane & 31)] = W[(size_t)(k0 + kk) * ldw + ns + (lane & 31)]; }
    asm volatile("s_waitcnt lgkmcnt(0)" ::: "memory");
    const int n = lane & 31, blk = lane >> 5; float v32[32];
#pragma unroll
    for (int i = 0; i < 32; ++i) v32[i] = scr[(32 * blk + i) * 33 + n];
    { const int sl = (k0 >> 5) + blk; pack_fp6_slot(v32, WT6 + (size_t)(nd + n) * K + (sl >> 2) * 128 + (sl & 3) * 16); }
    asm volatile("s_waitcnt lgkmcnt(0)" ::: "memory");
}
__device__ __forceinline__ void convert_stream(const float* src, bf16_t* dst, size_t n, int gthread, int nthreads) {
    for (size_t i = (size_t)gthread * 8; i < n; i += (size_t)nthreads * 8) {
        const f32x4 a = *(const f32x4*)(src + i), b = *(const f32x4*)(src + i + 4);
        u32x4 w; w.x = pk2(a[0], a[1]); w.y = pk2(a[2], a[3]); w.z = pk2(b[0], b[1]); w.w = pk2(b[2], b[3]);
        *(u32x4*)(dst + i) = w; }
}

__device__ __forceinline__ void p0_prologue(const Args& A, LAS unsigned char* lds, int tid, int lane, int wave, int G) {
    unsigned char* ws = A.ws;
    bf16_t* XN = (bf16_t*)(ws + WS_XN); float* GATES = (float*)(ws + WS_GATES); bf16_t* WIN16 = (bf16_t*)(ws + WS_WIN16); unsigned char* WIN8 = ws + WS_WIN8; unsigned char* XN8 = ws + WS_XN8;
    LAS float* wg = (LAS float*)lds;
    const int gw = blockIdx.x * NWAVES + wave, NGW = G * NWAVES;
    LAS unsigned char* stg6 = lds + 131072 + wave * 2048;
    f32x4 gvr[8], xv[8];
#pragma unroll
    for (int j = 0; j < 8; ++j) { gvr[j] = *(const f32x4*)(A.norm1_g + 4 * lane + 256 * j); if (gw < T) xv[j] = *(const f32x4*)(A.x + (size_t)gw * D + 4 * lane + 256 * j); }
#pragma unroll
    for (int hb = 0; hb < 2; ++hb) { float tg[32];
#pragma unroll
        for (int i = 0; i < 32; ++i) { const int idx = tid + (hb * 32 + i) * NTHR; tg[i] = A.w_in[(size_t)(idx >> 4) * WIN_LD + 8192 + (idx & 15)]; }
#pragma unroll
        for (int i = 0; i < 32; ++i) { const int idx = tid + (hb * 32 + i) * NTHR; wg[(idx & 15) * 2048 + (idx >> 4)] = tg[i]; } }
    __syncthreads();
    for (int row = gw; row < T; row += NGW) {
        float ss = 0.f;
#pragma unroll
        for (int j = 0; j < 8; ++j) { const f32x4 v = xv[j]; ss += (v[0] * v[0] + v[1] * v[1]) + (v[2] * v[2] + v[3] * v[3]); }
        const float rstd = 1.0f / sqrtf(wave_sum(ss) * (1.0f / D) + EPS);
        f32x4 xn[8];
        if (row + NGW < T) {
#pragma unroll
            for (int j = 0; j < 8; ++j) xn[j] = *(const f32x4*)(A.x + (size_t)(row + NGW) * D + 4 * lane + 256 * j); }
        float acc[16];
#pragma unroll
        for (int g = 0; g < 16; ++g) acc[g] = 0.f;
#pragma unroll
        for (int j = 0; j < 8; ++j) { const f32x4 v = xv[j] * rstd * gvr[j];
            u32x2 w; w.x = pk2(v[0], v[1]); w.y = pk2(v[2], v[3]);
            if (N16 > 0) *(u32x2*)(XN + (size_t)row * D + 4 * lane + 256 * j) = w;
#if IN_FP6
            {
              float am = __builtin_fmaxf(__builtin_fmaxf(__builtin_fabsf(v[0]), __builtin_fabsf(v[1])), __builtin_fmaxf(__builtin_fabsf(v[2]), __builtin_fabsf(v[3])));
              am = __builtin_fmaxf(am, __shfl_xor(am, 1)); am = __builtin_fmaxf(am, __shfl_xor(am, 2)); am = __builtin_fmaxf(am, __shfl_xor(am, 4));
              const unsigned E = fp6_block_exp(am); const unsigned p = enc4_e2m3(v[0], v[1], v[2], v[3], __uint_as_float((254u - E) << 23));
              LAS unsigned char* sl = stg6 + (8 * j + (lane >> 3)) * 32;
              sl[3 * (lane & 7)] = (unsigned char)p; sl[3 * (lane & 7) + 1] = (unsigned char)(p >> 8); sl[3 * (lane & 7) + 2] = (unsigned char)(p >> 16);
              *(LAS u32x2*)(sl + 24) = (u32x2){E * 0x01010101u, 0u}; }
#endif
#if !IN_FP6
            { int p8 = 0; p8 = __builtin_amdgcn_cvt_pk_fp8_f32(v[0] * XN8_SCALE, v[1] * XN8_SCALE, p8, false); p8 = __builtin_amdgcn_cvt_pk_fp8_f32(v[2] * XN8_SCALE, v[3] * XN8_SCALE, p8, true); *(int*)(XN8 + (size_t)row * D + 4 * lane + 256 * j) = p8; }
#endif
            const LAS float* wgj = wg + 4 * lane + 256 * j;
#pragma unroll
            for (int g = 0; g < 16; ++g) { const f32x4 w4 = *(const LAS f32x4*)(wgj + g * 2048); acc[g] += (v[0] * w4[0] + v[1] * w4[1]) + (v[2] * w4[2] + v[3] * w4[3]); }
            __builtin_amdgcn_sched_barrier(0); }
#pragma unroll
        for (int j = 0; j < 8; ++j) xv[j] = xn[j];
#pragma unroll
        for (int i = 0; i < 8; ++i) { const float send = (lane & 1) ? acc[i] : acc[i + 8], keep = (lane & 1) ? acc[i + 8] : acc[i]; acc[i] = keep + __shfl_xor(send, 1); }
#pragma unroll
        for (int i = 0; i < 4; ++i) { const float send = (lane & 2) ? acc[i] : acc[i + 4], keep = (lane & 2) ? acc[i + 4] : acc[i]; acc[i] = keep + __shfl_xor(send, 2); }
#pragma unroll
        for (int i = 0; i < 2; ++i) { const float send = (lane & 4) ? acc[i] : acc[i + 2], keep = (lane & 4) ? acc[i + 2] : acc[i]; acc[i] = keep + __shfl_xor(send, 4); }
        { const float send = (lane & 8) ? acc[0] : acc[1], keep = (lane & 8) ? acc[1] : acc[0]; acc[0] = keep + __shfl_xor(send, 8); }
        float tot = acc[0]; tot += __shfl_xor(tot, 16); tot += __shfl_xor(tot, 32);
        const int gidx = ((lane & 1) << 3) | ((lane & 2) << 1) | ((lane & 4) >> 1) | ((lane & 8) >> 3);
        if (lane < 16) GATES[(size_t)row * 16 + gidx] = tot;
#if IN_FP6
        { const u32x4 s0 = *(const LAS u32x4*)(stg6 + 32 * lane), s1 = *(const LAS u32x4*)(stg6 + 32 * lane + 16);
          unsigned char* rp = XN8 + (size_t)row * D + (lane >> 2) * 128 + (lane & 3) * 16; *(u32x4*)rp = s0; *(u32x4*)(rp + 64) = s1; }
#endif
    }
    __syncthreads();
#if IN_FP6 && defined(P0_SUBPHASE6)
    { LAS float* st = (LAS float*)(lds + wave * 9216);
      for (int row = gw; row < T; row += NGW) {
          u32x4 xr[4];
#pragma unroll
          for (int j = 0; j < 4; ++j) xr[j] = *(const u32x4*)(XN + (size_t)row * D + 8 * lane + 512 * j);
#pragma unroll
          for (int j = 0; j < 4; ++j) { const int c = 8 * lane + 512 * j; LAS float* d = st + 36 * (c >> 5) + (c & 31);
              *(LAS f32x4*)d = (f32x4){bflo(xr[j].x), bfhi(xr[j].x), bflo(xr[j].y), bfhi(xr[j].y)}; *(LAS f32x4*)(d + 4) = (f32x4){bflo(xr[j].z), bfhi(xr[j].z), bflo(xr[j].w), bfhi(xr[j].w)}; }
          f32x4 t8[8];
#pragma unroll
          for (int i = 0; i < 8; ++i) t8[i] = *(const LAS f32x4*)(st + 36 * lane + 4 * i);
          pack_fp6_slot8(t8, XN8 + (size_t)row * D + 32 * lane); } }
    __syncthreads();
#endif
    for (int i = (int)((blockIdx.x + (unsigned)(G >> 1)) % (unsigned)G) * NTHR + tid; i < 16 * 384; i += G * NTHR) {     const int head = i / 384, i0 = i % 384 - 32; f32x4 v4;
#pragma unroll
        for (int e = 0; e < 4; ++e) { const int idx = i0 + e, rel = idx - 128, n = rel < 0 ? -rel : rel;
            const int bk = (n < 8 ? n : n < 12 ? 8 : n < 16 ? 9 : n < 23 ? 10 : n < 32 ? 11 : n < 46 ? 12 : n < 64 ? 13 : n < 91 ? 14 : 15) + (rel > 0 ? 16 : 0);
            const float bv = A.rel_bias[bk * 16 + head]; v4[e] = (idx >= 0 && idx <= 256) ? bv * 1.4426950408889634f : 0.f; }
        *(f32x4*)(ws + WS_B4G + (size_t)i * 16) = v4; }
    LAS float* scr = (LAS float*)(lds + wave * 8704);
    constexpr int NBLK = NIN / 32, NITEMS = (D / 64) * NBLK;
    for (int it = gw; it < NITEMS; it += NGW) { if (it % NBLK < N16 / 32) transpose_item(A.w_in, WIN_LD, D, NBLK, WIN16, scr, it, lane, true); else { if (IN_FP6) transpose_item6<true>(A.w_in, WIN_LD, D, NBLK, WIN8, scr, it, lane); else transpose_item8<true>(A.w_in, WIN_LD, D, NBLK, WIN8, scr, it, lane); } }
}

__device__ __forceinline__ float logsigmoidf_(float x) { return fminf(x, 0.f) - log1pf(__expf(-fabsf(x))); }
__device__ __forceinline__ void gate_scan(const Args& A, LAS unsigned char* lds, int chain, int tid, int lane, int wave) {
    unsigned char* ws = A.ws;
    const float* GATES = (const float*)(ws + WS_GATES);
    float *U = (float*)(ws + WS_U), *MX = (float*)(ws + WS_MX), *WI = (float*)(ws + WS_WI), *WK = (float*)(ws + WS_WK), *MR = (float*)(ws + WS_MR), *DEC = (float*)(ws + WS_DEC);
    LAS float* BL = (LAS float*)lds; LAS float* PA = BL + 64; LAS float* MC = BL + 128; LAS float* MN = BL + 192;
    const int dir = chain & 1, bh = chain >> 1, b = bh >> 2, h = bh & 3;
    const float bi = A.gate_b[(dir * 2 + 0) * 4 + h], bf = A.gate_b[(dir * 2 + 1) * 4 + h];
    float bc[8], uu[8], pm[8];
#pragma unroll
    for (int i = 0; i < 8; ++i) { const int c = wave * 8 + i; const size_t t = (size_t)b * SEQ + 64 * c + lane;
        const float gi = GATES[t * 16 + dir * 8 + h] + bi, gf = GATES[t * 16 + dir * 8 + 4 + h] + bf;
        float s = logsigmoidf_(gf);
        if (!dir) {
#pragma unroll
            for (int o = 1; o < 64; o <<= 1) { const float t2 = __shfl_up(s, o); if (lane >= o) s += t2; }
        } else {
#pragma unroll
            for (int o = 1; o < 64; o <<= 1) { const float t2 = __shfl_down(s, o); if (lane + o < 64) s += t2; }
        }
        float u = gi - s, p = u;
        if (!dir) {
#pragma unroll
            for (int o = 1; o < 64; o <<= 1) { const float t2 = __shfl_up(p, o); if (lane >= o) p = fmaxf(p, t2); }
        } else {
#pragma unroll
            for (int o = 1; o < 64; o <<= 1) { const float t2 = __shfl_down(p, o); if (lane + o < 64) p = fmaxf(p, t2); }
        }
        bc[i] = s; uu[i] = u; pm[i] = p;
        const float blast = __shfl(s, dir ? 0 : 63), pall = __shfl(p, dir ? 0 : 63);
        if (lane == 0) { BL[c] = blast; PA[c] = pall; }
    }
    __syncthreads();
    if (tid == 0) { float m = 0.f; for (int ci = 0; ci < 64; ++ci) { const int c = dir ? 63 - ci : ci; MC[c] = m; m = BL[c] + fmaxf(m, PA[c]); MN[c] = m; } }
    __syncthreads();
#pragma unroll
    for (int i = 0; i < 8; ++i) { const int c = wave * 8 + i; const size_t o = (size_t)chain * SEQ + 64 * c + lane;
        const float m = MC[c], mn = MN[c], bl = BL[c], mx = fmaxf(m, pm[i]);
        U[o] = uu[i]; MX[o] = mx; WI[o] = __expf(m - mx); MR[o] = bc[i] + mx; WK[o] = __expf(bl + uu[i] - mn);
        if (lane == 0) DEC[chain * 64 + c] = __expf(bl + m - mn); }
    __syncthreads();
}

__device__ __forceinline__ unsigned offb(unsigned row, unsigned ch) { return 256u * row + 16u * (ch ^ (((row & 3u) << 2) | ((row >> 2) & 3u))); }
__device__ __forceinline__ int t5_bucket_abs(int n) { return n < 8 ? n : n < 12 ? 8 : n < 16 ? 9 : n < 23 ? 10 : n < 32 ? 11 : n < 46 ? 12 : n < 64 ? 13 : n < 91 ? 14 : 15; }
constexpr int AT_BUF = 65536, AT_RSTD = 131072, AT_BIAS = AT_RSTD + 1024, AT_B4B = 6144, AT_GQK = AT_BIAS + 2 * AT_B4B;

__device__ __forceinline__ void attn_chunk_load(const bf16_t* AK, const bf16_t* AV, LAS unsigned char* buf, int b, int qb, int kvh, int ck, int wave, int lane) {
#pragma unroll
    for (int ii = 0; ii < 4; ++ii) { const int i = wave * 4 + ii, row = 4 * i + (lane >> 4), cpos = lane & 15;
        const int ch = cpos ^ (((row & 3) << 2) | ((row >> 2) & 3));
        int kp = 128 * (qb - 1) + 128 * ck + row; kp = kp < 0 ? 0 : (kp > SEQ - 1 ? SEQ - 1 : kp);
        const size_t so = (size_t)(b * SEQ + kp) * 512 + kvh * 128 + 8 * ch;
        GLDS16(AK + so, buf + i * 1024); GLDS16(AV + so, buf + 32768 + i * 1024); }
}
static_assert(AT_GQK + 512 <= MISC_OFF, "LDS map");
__device__ __forceinline__ void attn_phase(const Args& A, LAS unsigned char* lds, int vcu, int G, int tid, int lane, int wave) {
    unsigned char* ws = A.ws;
    const bf16_t *AQ = (const bf16_t*)(ws + WS_AQ), *AK = (const bf16_t*)(ws + WS_AK), *AV = (const bf16_t*)(ws + WS_AV); unsigned char* HA8 = ws + WS_HA8;
    const unsigned char* B4G = ws + WS_B4G;
    const int g = lane >> 4, ql = lane & 15, T0 = wave >> 1;
    LAS float* RSTD = (LAS float*)(lds + AT_RSTD); LAS float* GQK = (LAS float*)(lds + AT_GQK);
    if (tid < 128) GQK[tid] = A.gq[tid] * A.gk[tid] * 0.08838834764831845f;
    int gc = 0, ui = 0;
    u32x4 qraw[4];
    if (vcu < 2048) { const int head = vcu & 15, qb = (vcu >> 4) & 31, b = vcu >> 9;
        attn_chunk_load(AK, AV, lds, b, qb, head >> 2, 0, wave, lane);
        if (wave < 6) GLDS16(B4G + (size_t)head * 6144 + wave * 1024 + lane * 16, lds + AT_BIAS + wave * 1024);
#pragma unroll
        for (int s4 = 0; s4 < 4; ++s4) qraw[s4] = *(const u32x4*)(AQ + ((size_t)b * SEQ + 128 * qb + 16 * wave + ql) * D + head * 128 + 32 * s4 + 8 * g); }
    for (int unit = vcu; unit < 2048; unit += G, ++ui) {
        const int head = unit & 15, kvh = head >> 2, qb = (unit >> 4) & 31, b = unit >> 9;
        const size_t trow = (size_t)b * SEQ + 128 * qb + 16 * wave + ql;
        const LAS f32x4* B4 = (const LAS f32x4*)(lds + AT_BIAS + (ui & 1) * AT_B4B);
        f32x4 o[8]; float mrun = A.sink[head] * 1.4426950408889634f, lrun = 1.0f;
#pragma unroll
        for (int n = 0; n < 8; ++n) o[n] = (f32x4){0.f, 0.f, 0.f, 0.f};
        VM_WAIT(); __syncthreads();
        bf16x8 qf[4];
        { float ss = 0.f;
#pragma unroll
            for (int s4 = 0; s4 < 4; ++s4)
#pragma unroll
                for (int j = 0; j < 4; ++j) { const float lo = bflo(qraw[s4][j]), hi = bfhi(qraw[s4][j]); ss += lo * lo + hi * hi; }
            ss += __shfl_xor(ss, 16); ss += __shfl_xor(ss, 32);
            const float rq = 1.0f / sqrtf(ss * (1.0f / 128.0f) + EPS);
#pragma unroll
            for (int s4 = 0; s4 < 4; ++s4) { const f32x4 g0 = *(const LAS f32x4*)(GQK + 32 * s4 + 8 * g), g1 = *(const LAS f32x4*)(GQK + 32 * s4 + 8 * g + 4);
                u32x4 w;
                w.x = cvtpk(bflo(qraw[s4].x) * rq * g0[0], bfhi(qraw[s4].x) * rq * g0[1]); w.y = cvtpk(bflo(qraw[s4].y) * rq * g0[2], bfhi(qraw[s4].y) * rq * g0[3]);
                w.z = cvtpk(bflo(qraw[s4].z) * rq * g1[0], bfhi(qraw[s4].z) * rq * g1[1]); w.w = cvtpk(bflo(qraw[s4].w) * rq * g1[2], bfhi(qraw[s4].w) * rq * g1[3]);
                qf[s4] = __builtin_bit_cast(bf16x8, w); } }
#pragma unroll
        for (int ck = 0; ck < 3; ++ck, ++gc) {
            LAS unsigned char* kb_ = lds + (gc & 1) * AT_BUF; LAS unsigned char* vb_ = kb_ + 32768; LAS float* rs = RSTD + (gc & 1) * 128;
            if (ck < 2) attn_chunk_load(AK, AV, lds + ((gc + 1) & 1) * AT_BUF, b, qb, kvh, ck + 1, wave, lane);
            else if (unit + G < 2048) { const int nu = unit + G, nh = nu & 15, nqb = (nu >> 4) & 31, nb = nu >> 9;
                attn_chunk_load(AK, AV, lds + ((gc + 1) & 1) * AT_BUF, nb, nqb, nh >> 2, 0, wave, lane);
                if (wave < 6) GLDS16(B4G + (size_t)nh * 6144 + wave * 1024 + lane * 16, lds + AT_BIAS + ((ui + 1) & 1) * AT_B4B + wave * 1024);
#pragma unroll
                for (int s4 = 0; s4 < 4; ++s4) qraw[s4] = *(const u32x4*)(AQ + ((size_t)nb * SEQ + 128 * nqb + 16 * wave + ql) * D + nh * 128 + 32 * s4 + 8 * g); }
            { const int row = 16 * wave + (lane >> 2), qtr = lane & 3; float s2 = 0.f;
#pragma unroll
                for (int i = 0; i < 4; ++i) { const u32x4 kk = *(const LAS u32x4*)(kb_ + offb(row, 4 * qtr + i));
#pragma unroll
                    for (int j = 0; j < 4; ++j) { const float lo = bflo(kk[j]), hi = bfhi(kk[j]); s2 += lo * lo + hi * hi; } }
                s2 += __shfl_xor(s2, 1); s2 += __shfl_xor(s2, 2);
                if (qtr == 0) rs[row] = 1.4426950408889634f / sqrtf(s2 * (1.0f / 128.0f) + EPS); }
            __syncthreads();
            const int jlo = (ck == 0) ? (qb == 0 ? 4 : T0) : 0, jhi = (ck == 2) ? (qb == 31 ? -1 : T0) : 3;
            const unsigned rlo = 8 * (ql >> 2) + (ql & 3);
            f32x4 sc[8]; float mx = mrun;
            const int relb = 128 * ck + 8 * g - 128 - 16 * wave - ql;
            const LAS f32x4* b4_l = B4 + (relb + 128 + 32);
#pragma unroll
            for (int j = 0; j < 4; ++j) {
                if (j >= jlo && j <= jhi) {
                    bf16x8 kf[2][4]; f32x4 rk[2], bb[2];
#pragma unroll
                    for (int hf = 0; hf < 2; ++hf) {
#pragma unroll
                        for (int s4 = 0; s4 < 4; ++s4) kf[hf][s4] = *(const LAS bf16x8*)(kb_ + offb(rlo + 4 * hf, 4 * s4 + g) + 8192 * j);
                        rk[hf] = *(const LAS f32x4*)(rs + 8 * g + 32 * j + 4 * hf); bb[hf] = b4_l[32 * j + 4 * hf]; }
#pragma unroll
                    for (int hf = 0; hf < 2; ++hf) { f32x4 a = (f32x4){0.f, 0.f, 0.f, 0.f};
#pragma unroll
                        for (int s4 = 0; s4 < 4; ++s4) a = MFMA16(kf[hf][s4], qf[s4], a);
                        const int c0 = 32 * j + 4 * hf;
                        if (ck == 1) {
#pragma unroll
                            for (int e = 0; e < 4; ++e) { const float v = a[e] * rk[hf][e] + bb[hf][e]; a[e] = v; mx = fmaxf(mx, v); }
                        } else if (ck == 0) {
#pragma unroll
                            for (int e = 0; e < 4; ++e) { const float v = (relb + (c0 + e) >= -128) ? a[e] * rk[hf][e] + bb[hf][e] : -1e30f; a[e] = v; mx = fmaxf(mx, v); }
                        } else {
#pragma unroll
                            for (int e = 0; e < 4; ++e) { const float v = (relb + (c0 + e) <= 128) ? a[e] * rk[hf][e] + bb[hf][e] : -1e30f; a[e] = v; mx = fmaxf(mx, v); }
                        }
                        sc[2 * j + hf] = a; }
                } else { sc[2 * j] = (f32x4){-1e30f, -1e30f, -1e30f, -1e30f}; sc[2 * j + 1] = sc[2 * j]; }
            }
            mx = fmaxf(mx, __shfl_xor(mx, 16)); mx = fmaxf(mx, __shfl_xor(mx, 32));
            const float alpha = __builtin_amdgcn_exp2f(mrun - mx); mrun = mx;
            float l = 0.f;
#pragma unroll
            for (int t = 0; t < 8; ++t)
#pragma unroll
                for (int e = 0; e < 4; ++e) { const float p = __builtin_amdgcn_exp2f(sc[t][e] - mx); sc[t][e] = p; l += p; }
            l += __shfl_xor(l, 16); l += __shfl_xor(l, 32);
            lrun = lrun * alpha + l;
            bf16x8 pf[4];
#pragma unroll
            for (int j = 0; j < 4; ++j) pf[j] = pack8(sc[2 * j], sc[2 * j + 1]);
            { const unsigned q4 = ql >> 2, p = ql & 3, r0 = 8 * g + q4;
#pragma unroll
                for (int n = 0; n < 8; ++n) o[n] = o[n] * alpha;
#pragma unroll
                for (int j = 0; j < 4; ++j) if (j >= jlo && j <= jhi) {
                    s16x4 v0[8], v1[8];
#pragma unroll
                    for (int n = 0; n < 8; ++n) {
                        v0[n] = __builtin_amdgcn_ds_read_tr16_b64_v4i16((LAS s16x4*)(vb_ + offb(r0, 2 * n + (p >> 1)) + 8 * (p & 1) + 8192 * j));
                        v1[n] = __builtin_amdgcn_ds_read_tr16_b64_v4i16((LAS s16x4*)(vb_ + offb(r0 + 4, 2 * n + (p >> 1)) + 8 * (p & 1) + 8192 * j)); }
#pragma unroll
                    for (int n = 0; n < 8; ++n) { bf16x8 vf; vf[0] = v0[n][0]; vf[1] = v0[n][1]; vf[2] = v0[n][2]; vf[3] = v0[n][3]; vf[4] = v1[n][0]; vf[5] = v1[n][1]; vf[6] = v1[n][2]; vf[7] = v1[n][3];
                        o[n] = MFMA16(vf, pf[j], o[n]); } } }
            VM_WAIT(); __syncthreads();
        }
        { const float sc8 = H8_SCALE / lrun;
#pragma unroll
            for (int n = 0; n < 8; ++n) { int p8 = 0;
                p8 = __builtin_amdgcn_cvt_pk_fp8_f32(o[n][0] * sc8, o[n][1] * sc8, p8, false); p8 = __builtin_amdgcn_cvt_pk_fp8_f32(o[n][2] * sc8, o[n][3] * sc8, p8, true);
                *(int*)(HA8 + trow * D + head * 128 + 16 * n + 4 * g) = p8; } }
    }
    __syncthreads();
}

__device__ __forceinline__ void ss_unit(const Args& A, LAS unsigned char* lds, int unit, int lane, int wave) {
    unsigned char* ws = A.ws;
    const bf16_t *Q = (const bf16_t*)(ws + WS_Q), *K = (const bf16_t*)(ws + WS_K); bf16_t* SS = (bf16_t*)(ws + WS_SS);
    const float *U = (const float*)(ws + WS_U), *MX = (const float*)(ws + WS_MX), *WK = (const float*)(ws + WS_WK);
    float *RS = (float*)(ws + WS_DEN), *AC = (float*)(ws + WS_AC);
    const int c = unit & 63, bh = unit >> 6, b = bh >> 2, h = bh & 3;
    const int g = lane >> 4, r = lane & 15;
    const size_t t0 = (size_t)b * SEQ + 64 * c;
    LAS float* RSX = (LAS float*)(lds + 131072);
    LAS unsigned char* QS = lds; LAS unsigned char* KS = lds + 65536;
    __syncthreads();
#pragma unroll
    for (int ii = 0; ii < 8; ++ii) { const int row = 8 * wave + ii; const size_t go = (t0 + row) * D + h * 512 + 8 * (lane ^ (row & 15));
        GLDS16(Q + go, QS + row * 1024); GLDS16(K + go, KS + row * 1024); }
    VM_WAIT(); __syncthreads();
    { const int m = wave & 3, sh = wave >> 2;
        f32x4 acc[2];
#pragma unroll
        for (int n = 0; n < 2; ++n) acc[n] = (f32x4){0.f, 0.f, 0.f, 0.f};
#pragma unroll 8
        for (int ks = 0; ks < 16; ++ks) { const bf16x8 qfr = *(const LAS bf16x8*)(QS + (16 * m + r) * 1024 + 16 * ((4 * ks + g) ^ r));
#pragma unroll
            for (int n = 0; n < 2; ++n) { const bf16x8 kfr = *(const LAS bf16x8*)(KS + (32 * sh + 16 * n + r) * 1024 + 16 * ((4 * ks + g) ^ r)); acc[n] = MFMA16(kfr, qfr, acc[n]); } }
        const int j = 16 * m + r;
        float mxv[2]; f32x4 usv[2][2];
#pragma unroll
        for (int d = 0; d < 2; ++d) { const int ch = bh * 2 + d; mxv[d] = MX[(size_t)ch * SEQ + 64 * c + j];
#pragma unroll
            for (int n = 0; n < 2; ++n) usv[d][n] = *(const f32x4*)(U + (size_t)ch * SEQ + 64 * c + 32 * sh + 16 * n + 4 * g); }
#pragma unroll
        for (int d = 0; d < 2; ++d) { const int ch = bh * 2 + d; const float mxj = mxv[d]; float rsum = 0.f;
#pragma unroll
            for (int n = 0; n < 2; ++n) { const int s0 = 32 * sh + 16 * n + 4 * g; const f32x4 us = usv[d][n];
                float v[4];
#pragma unroll
                for (int e = 0; e < 4; ++e) { const int sx = s0 + e; const bool ok = d ? (sx >= j) : (sx <= j); v[e] = ok ? acc[n][e] * __expf(us[e] - mxj) : 0.f; rsum += v[e]; }
                u32x2 w; w.x = cvtpk(v[0], v[1]); w.y = cvtpk(v[2], v[3]);
                *(u32x2*)(SS + ((size_t)(ch * 64 + c) * 64 + j) * 64 + s0) = w; }
            rsum += __shfl_xor(rsum, 16); rsum += __shfl_xor(rsum, 32);
            if (g == 0) RSX[(d * 2 + sh) * 64 + j] = rsum; } }
    { const int d = wave >> 2, m = wave & 3, ch = bh * 2 + d, dk0 = 128 * m + 8 * r; float a8[8];
#pragma unroll
        for (int e = 0; e < 8; ++e) a8[e] = 0.f;
        f32x4 wk4[4]; u32x4 kk16[16];
#pragma unroll
        for (int i = 0; i < 4; ++i) wk4[i] = *(const f32x4*)(WK + (size_t)ch * SEQ + 64 * c + 16 * g + 4 * i);
#pragma unroll
        for (int i = 0; i < 16; ++i) kk16[i] = *(const LAS u32x4*)(KS + (16 * g + i) * 1024 + 16 * ((16 * m + r) ^ i));
#pragma unroll
        for (int i = 0; i < 16; ++i) { const float w = wk4[i >> 2][i & 3];
#pragma unroll
            for (int q = 0; q < 4; ++q) { a8[2 * q] += w * bflo(kk16[i][q]); a8[2 * q + 1] += w * bfhi(kk16[i][q]); } }
#pragma unroll
        for (int e = 0; e < 8; ++e) { a8[e] += __shfl_xor(a8[e], 16); a8[e] += __shfl_xor(a8[e], 32); }
        if (g == 0) { float* ap = AC + ((size_t)(ch * 64 + c)) * 512 + dk0; *(f32x4*)ap = (f32x4){a8[0], a8[1], a8[2], a8[3]}; *(f32x4*)(ap + 4) = (f32x4){a8[4], a8[5], a8[6], a8[7]}; } }
    __syncthreads();
    if (wave < 2) RS[(size_t)(bh * 2 + wave) * SEQ + 64 * c + lane] = RSX[(wave * 2) * 64 + lane] + RSX[(wave * 2 + 1) * 64 + lane];
    __syncthreads();
}

constexpr int ML_SMALL = 98304, ML_SMALL_STRIDE = 17408, ML_SMALL_END = ML_SMALL + 2 * ML_SMALL_STRIDE;
struct MlLaneOff { unsigned q[2], k[2]; };
__device__ __forceinline__ MlLaneOff ml_lane_off(int wave, int lane) {
    MlLaneOff o;
#pragma unroll
    for (int ii = 0; ii < 2; ++ii) { const int i = 2 * wave + ii;
        { const int row = 4 * i + (lane >> 4), cpos = lane & 15, sch = cpos ^ (row & 15); o.q[ii] = (unsigned)(row * D + 8 * sch) * 2u; }
        { const int line = 4 * i + (lane >> 4), cpos = lane & 15, c16 = cpos ^ (line & 15), row = 2 * line + (c16 >> 3), c8 = c16 & 7; o.k[ii] = (unsigned)(row * 64 + 8 * c8) * 2u; } }
    return o;
}
__device__ __forceinline__ void ml_issue_piece(const bf16_t* Q, const bf16_t* KT, LAS unsigned char* lds, const MlLaneOff& lo, int step, int slot, int dir, int b, int h, int bh, int wave) {
    const int ci = step >> 2, p = step & 3, c = dir ? 63 - ci : ci;
    LAS unsigned char* qp = lds + slot * 32768; LAS unsigned char* kp = qp + 16384;
    const char* qb_ = (const char*)(Q + ((size_t)b * SEQ + 64 * c) * D + h * 512 + 128 * p);
    const char* kb_ = (const char*)(KT + (((size_t)(bh * 64 + c)) * 512 + 128 * p) * 64);
#pragma unroll
    for (int ii = 0; ii < 2; ++ii) { const int i = 2 * wave + ii;
        GLDS16(qb_ + lo.q[ii], qp + i * 1024);
        GLDS16(kb_ + lo.k[ii], kp + i * 1024); }
}
__device__ __forceinline__ void ml_issue_small(const bf16_t* SS, const bf16_t* VT, const float* WI, const float* WK, const float* DEC, LAS unsigned char* lds, int ci, int dir, int ch, int bh, int dvblk, int wave, int lane) {
    const int c = dir ? 63 - ci : ci; LAS unsigned char* sm = lds + ML_SMALL + (ci & 1) * ML_SMALL_STRIDE;
    GLDS16(SS + ((size_t)(ch * 64 + c)) * 4096 + wave * 512 + lane * 8, sm + wave * 1024);
    GLDS16(VT + (((size_t)(bh * 64 + c)) * 512 + 64 * dvblk) * 64 + wave * 512 + lane * 8, sm + 8192 + wave * 1024);
    if (wave == 0) GLDS4(WI + (size_t)ch * SEQ + 64 * c + lane, sm + 16384);
    if (wave == 1) GLDS4(WK + (size_t)ch * SEQ + 64 * c + lane, sm + 16640);
    if (wave == 2) GLDS4(DEC + ch * 64 + c + lane, sm + 16896);
}
static_assert(ML_SMALL_END + 8192 <= MISC_OFF, "LDS map");
#define ML_BAR() do { asm volatile("" ::: "memory"); __builtin_amdgcn_s_barrier(); asm volatile("" ::: "memory"); } while (0)
#define ML_WAIT(n) asm volatile("s_waitcnt vmcnt(" #n ")" ::: "memory")

__device__ __forceinline__ void mlstm_nscan(const Args& A, int idx) {
    unsigned char* ws = A.ws;
    const float *AC = (const float*)(ws + WS_AC), *DEC = (const float*)(ws + WS_DEC); float* NC = (float*)(ws + WS_NC);
    const int ch = __builtin_amdgcn_readfirstlane(idx >> 9), dk = idx & 511, dir = ch & 1;
    float ac[64];
#pragma unroll
    for (int ci = 0; ci < 64; ++ci) { const int c = dir ? 63 - ci : ci; ac[ci] = AC[((size_t)(ch * 64 + c)) * 512 + dk]; }
    const int decl = __float_as_int(DEC[ch * 64 + (threadIdx.x & 63)]);
    __builtin_amdgcn_sched_barrier(0);
    float n = 0.f;
#pragma unroll
    for (int ci = 0; ci < 64; ++ci) { const int c = dir ? 63 - ci : ci; NC[((size_t)(ch * 64 + c)) * 512 + dk] = n; n = __int_as_float(__builtin_amdgcn_readlane(decl, c)) * n + ac[ci]; }
}

__device__ __forceinline__ void mlstm_unit(const Args& A, LAS unsigned char* lds, int unit, int tid, int lane, int wave) {
    unsigned char* ws = A.ws;
    const bf16_t *Q = (const bf16_t*)(ws + WS_Q), *KT = (const bf16_t*)(ws + WS_KT), *VT = (const bf16_t*)(ws + WS_VT), *SS = (const bf16_t*)(ws + WS_SS);
    const float *WI = (const float*)(ws + WS_WI), *WK = (const float*)(ws + WS_WK), *DEC = (const float*)(ws + WS_DEC);
    const int ch = unit >> 3, dvblk = unit & 7, dir = ch & 1, bh = ch >> 1, b = bh >> 2, h = bh & 3;
    bf16_t* HOUT = (bf16_t*)(ws + (dir ? WS_AQ : WS_K));
    const int g = lane >> 4, r = lane & 15, dvt = wave & 3, dkh = wave >> 2;
    f32x4 C[16];
#pragma unroll
    for (int i = 0; i < 16; ++i) C[i] = (f32x4){0.f, 0.f, 0.f, 0.f};
    f32x4 hT[4];
#pragma unroll
    for (int m = 0; m < 4; ++m) hT[m] = (f32x4){0.f, 0.f, 0.f, 0.f};
    bf16x8 vw[2]; float dec = 0.f;
    unsigned qoff[2], koff[2][2];
#pragma unroll
    for (int kl = 0; kl < 2; ++kl) qoff[kl] = r * 256 + 16 * ((8 * dkh + 4 * kl + g) ^ r);
#pragma unroll
    for (int il = 0; il < 2; ++il)
#pragma unroll
        for (int k2 = 0; k2 < 2; ++k2) { const unsigned rl_ = 8 * (r >> 2) + (r & 3) + 4 * il, ln_ = rl_ >> 1, c16 = (rl_ & 1) * 8 + 4 * k2 + g; koff[il][k2] = 16384 + ln_ * 256 + 16 * (c16 ^ (ln_ & 15)) + 8192 * dkh; }
    ml_issue_small(SS, VT, WI, WK, DEC, lds, 0, dir, ch, bh, dvblk, wave, lane);
    const MlLaneOff lo = ml_lane_off(wave, lane);
    ml_issue_piece(Q, KT, lds, lo, 0, 0, dir, b, h, bh, wave);
    ml_issue_piece(Q, KT, lds, lo, 1, 1, dir, b, h, bh, wave);
    ML_WAIT(4); ML_BAR();
    int slot = 0;
    for (int ci = 0; ci < 64; ++ci) {
        const int c = dir ? 63 - ci : ci;
        LAS unsigned char* sm = lds + ML_SMALL + (ci & 1) * ML_SMALL_STRIDE;
#pragma unroll
        for (int p = 0; p < 4; ++p) {
            const int step = ci * 4 + p;
            const bool more = (step + 2 < 256);
            if (p == 0 && ci + 1 < 64) ml_issue_small(SS, VT, WI, WK, DEC, lds, ci + 1, dir, ch, bh, dvblk, wave, lane);
            if (more) { const int s2 = slot == 0 ? 2 : slot - 1; ml_issue_piece(Q, KT, lds, lo, step + 2, s2, dir, b, h, bh, wave); }
            LAS unsigned char* qp = lds + slot * 32768;
            if (p == 0) {
                dec = *(const LAS float*)(sm + 16896);
#pragma unroll
                for (int k2 = 0; k2 < 2; ++k2) {
                    const u32x4 vraw = *(const LAS u32x4*)(sm + 8192 + (16 * dvt + r) * 128 + 64 * k2 + 16 * g);
                    const f32x4 w0 = *(const LAS f32x4*)(sm + 16640 + (32 * k2 + 8 * g) * 4), w1 = *(const LAS f32x4*)(sm + 16640 + (32 * k2 + 8 * g + 4) * 4);
                    u32x4 ww; ww.x = cvtpk(bflo(vraw.x) * w0[0], bfhi(vraw.x) * w0[1]); ww.y = cvtpk(bflo(vraw.y) * w0[2], bfhi(vraw.y) * w0[3]);
                    ww.z = cvtpk(bflo(vraw.z) * w1[0], bfhi(vraw.z) * w1[1]); ww.w = cvtpk(bflo(vraw.w) * w1[2], bfhi(vraw.w) * w1[3]);
                    vw[k2] = __builtin_bit_cast(bf16x8, ww); }
            }
            bf16x8 qfr[2][4], kfr[4][2];
#pragma unroll
            for (int kl = 0; kl < 2; ++kl)
#pragma unroll
                for (int m = 0; m < 4; ++m) qfr[kl][m] = *(const LAS bf16x8*)(qp + qoff[kl] + 4096 * m);
#pragma unroll
            for (int il = 0; il < 4; ++il)
#pragma unroll
                for (int k2 = 0; k2 < 2; ++k2) kfr[il][k2] = *(const LAS bf16x8*)(qp + koff[il & 1][k2] + 4096 * (il >> 1));
            __builtin_amdgcn_sched_barrier(0);
#pragma unroll
            for (int kl = 0; kl < 2; ++kl) { const bf16x8 cf = pack8(C[4 * p + 2 * kl], C[4 * p + 2 * kl + 1]);
#pragma unroll
                for (int m = 0; m < 4; ++m) hT[m] = MFMA16(cf, qfr[kl][m], hT[m]); }
#pragma unroll
            for (int il = 0; il < 4; ++il) { C[4 * p + il] = C[4 * p + il] * dec;
#pragma unroll
                for (int k2 = 0; k2 < 2; ++k2) C[4 * p + il] = MFMA16(kfr[il][k2], vw[k2], C[4 * p + il]); }
            if (p == 3) {
                LAS unsigned char* xch = lds + ML_SMALL_END + (dvt * 2 + dkh) * 1024;
#pragma unroll
                for (int mm = 0; mm < 2; ++mm) { const f32x4 t4 = hT[2 * (1 - dkh) + mm]; u32x2 w; w.x = cvtpk(t4[0], t4[1]); w.y = cvtpk(t4[2], t4[3]); *(LAS u32x2*)(xch + mm * 512 + lane * 8) = w; }
                asm volatile("s_waitcnt lgkmcnt(0)" ::: "memory"); ML_BAR();
                const LAS unsigned char* xin = lds + ML_SMALL_END + (dvt * 2 + (1 - dkh)) * 1024;
#pragma unroll
                for (int mm = 0; mm < 2; ++mm) { const int m = 2 * dkh + mm;
                    const u32x2 pw = *(const LAS u32x2*)(xin + mm * 512 + lane * 8);
                    f32x4 hv = hT[m] + (f32x4){bflo(pw.x), bfhi(pw.x), bflo(pw.y), bfhi(pw.y)};
                    const float wi = *(const LAS float*)(sm + 16384 + (16 * m + r) * 4); hv = hv * wi;
#pragma unroll
                    for (int k2 = 0; k2 < 2; ++k2) { const bf16x8 sf = *(const LAS bf16x8*)(sm + (16 * m + r) * 128 + 64 * k2 + 16 * g);
                        const u32x4 vraw = *(const LAS u32x4*)(sm + 8192 + (16 * dvt + r) * 128 + 64 * k2 + 16 * g);
                        hv = MFMA16(__builtin_bit_cast(bf16x8, vraw), sf, hv); }
                    const size_t tok = (size_t)b * SEQ + 64 * c + 16 * m + r;
                    u32x2 w; w.x = cvtpk(hv[0], hv[1]); w.y = cvtpk(hv[2], hv[3]); *(u32x2*)(HOUT + tok * D + h * 512 + 64 * dvblk + 16 * dvt + 4 * g) = w; }
#pragma unroll
                for (int m = 0; m < 4; ++m) hT[m] = (f32x4){0.f, 0.f, 0.f, 0.f};
            }
            if (!more) { ML_WAIT(0); }
            else if (p == 0) { if (ci + 1 < 64) { if (wave < 3) ML_WAIT(7); else ML_WAIT(6); } else ML_WAIT(4); }
            else if (p == 3) { ML_WAIT(6); }
            else ML_WAIT(4);
            ML_BAR();
            slot = slot == 2 ? 0 : slot + 1;
        }
    }
    __syncthreads();
}

__device__ __forceinline__ void hm_rows(const Args& A, int lane, int gw, int NGW) {
    unsigned char* ws = A.ws;
    const bf16_t *HF = (const bf16_t*)(ws + WS_K), *HB = (const bf16_t*)(ws + WS_AQ), *SO = (const bf16_t*)(ws + WS_SO), *Q = (const bf16_t*)(ws + WS_Q); unsigned char* HM8 = ws + WS_HM8;
    const float *RS = (const float*)(ws + WS_DEN), *MR = (const float*)(ws + WS_MR), *WI = (const float*)(ws + WS_WI), *NC = (const float*)(ws + WS_NC);
    f32x4 g0[4], g1[4];
#pragma unroll
    for (int h = 0; h < 4; ++h) { g0[h] = *(const f32x4*)(A.mnorm_g + h * 512 + 8 * lane); g1[h] = *(const f32x4*)(A.mnorm_g + h * 512 + 8 * lane + 4); }
    for (int row = gw; row < T; row += NGW) { const int b = row >> 12, s = row & 4095, c = s >> 6;
        u32x4 qv[4], av[4], bv[4], sv[4]; f32x4 nf0[4], nf1[4], nb0[4], nb1[4]; float wif[4], wib[4], rsf[4], rsb[4], mrf[4], mrb[4];
#pragma unroll
        for (int h = 0; h < 4; ++h) { const int chf = (b * 4 + h) * 2, chb = chf + 1;
            const size_t off = (size_t)row * D + h * 512 + 8 * lane;
            qv[h] = *(const u32x4*)(Q + off); av[h] = *(const u32x4*)(HF + off); bv[h] = *(const u32x4*)(HB + off); sv[h] = *(const u32x4*)(SO + off);
            const float* nf = NC + ((size_t)(chf * 64 + c)) * 512 + 8 * lane; const float* nb = NC + ((size_t)(chb * 64 + c)) * 512 + 8 * lane;
            nf0[h] = *(const f32x4*)nf; nf1[h] = *(const f32x4*)(nf + 4); nb0[h] = *(const f32x4*)nb; nb1[h] = *(const f32x4*)(nb + 4);
            wif[h] = WI[(size_t)chf * SEQ + s]; wib[h] = WI[(size_t)chb * SEQ + s]; rsf[h] = RS[(size_t)chf * SEQ + s]; rsb[h] = RS[(size_t)chb * SEQ + s]; mrf[h] = MR[(size_t)chf * SEQ + s]; mrb[h] = MR[(size_t)chb * SEQ + s]; }
        __builtin_amdgcn_sched_barrier(0);
#pragma unroll
        for (int h = 0; h < 4; ++h) {
            const size_t off = (size_t)row * D + h * 512 + 8 * lane;
            const u32x4 q4 = qv[h];
            float df = bflo(q4.x) * nf0[h][0] + bfhi(q4.x) * nf0[h][1] + bflo(q4.y) * nf0[h][2] + bfhi(q4.y) * nf0[h][3] + bflo(q4.z) * nf1[h][0] + bfhi(q4.z) * nf1[h][1] + bflo(q4.w) * nf1[h][2] + bfhi(q4.w) * nf1[h][3];
            float db = bflo(q4.x) * nb0[h][0] + bfhi(q4.x) * nb0[h][1] + bflo(q4.y) * nb0[h][2] + bfhi(q4.y) * nb0[h][3] + bflo(q4.z) * nb1[h][0] + bfhi(q4.z) * nb1[h][1] + bflo(q4.w) * nb1[h][2] + bfhi(q4.w) * nb1[h][3];
            df = wave_sum(df); db = wave_sum(db);
            const float denf = wif[h] * df + rsf[h], denb = wib[h] * db + rsb[h];
            const float rdf = 1.0f / fmaxf(fabsf(denf), __expf(-mrf[h]));
            const float rdb = 1.0f / fmaxf(fabsf(denb), __expf(-mrb[h]));
            const u32x4 a = av[h], bq = bv[h], so = sv[h];
            float v[8]; float ss = 0.f;
#pragma unroll
            for (int j = 0; j < 4; ++j) { v[2 * j] = bflo(a[j]) * rdf + bflo(bq[j]) * rdb; v[2 * j + 1] = bfhi(a[j]) * rdf + bfhi(bq[j]) * rdb; ss += v[2 * j] * v[2 * j] + v[2 * j + 1] * v[2 * j + 1]; }
            const float rs = 1.0f / sqrtf(wave_sum(ss) * (1.0f / 512.0f) + EPS);
            const float r8 = rs * H8_SCALE; int p0 = 0, p1 = 0;
            p0 = __builtin_amdgcn_cvt_pk_fp8_f32(v[0] * r8 * g0[h][0] * bflo(so.x), v[1] * r8 * g0[h][1] * bfhi(so.x), p0, false); p0 = __builtin_amdgcn_cvt_pk_fp8_f32(v[2] * r8 * g0[h][2] * bflo(so.y), v[3] * r8 * g0[h][3] * bfhi(so.y), p0, true);
            p1 = __builtin_amdgcn_cvt_pk_fp8_f32(v[4] * r8 * g1[h][0] * bflo(so.z), v[5] * r8 * g1[h][1] * bfhi(so.z), p1, false); p1 = __builtin_amdgcn_cvt_pk_fp8_f32(v[6] * r8 * g1[h][2] * bflo(so.w), v[7] * r8 * g1[h][3] * bfhi(so.w), p1, true);
            u32x2 w; w.x = (unsigned)p0; w.y = (unsigned)p1;
            *(u32x2*)(HM8 + off) = w; } }
}

constexpr size_t WS_SC8 = 7 * MiB;
__device__ __forceinline__ float wave_max(float v) {
#pragma unroll
    for (int o = 1; o < 64; o <<= 1) v = __builtin_fmaxf(v, __shfl_xor(v, o));
    return v;
}
__device__ __forceinline__ unsigned pack_i8(const f32x4 v, float inv) {
    const int q0 = (int)__builtin_rintf(v[0] * inv), q1 = (int)__builtin_rintf(v[1] * inv), q2 = (int)__builtin_rintf(v[2] * inv), q3 = (int)__builtin_rintf(v[3] * inv);
    return ((unsigned)q0 & 0xffu) | (((unsigned)q1 & 0xffu) << 8) | (((unsigned)q2 & 0xffu) << 16) | ((unsigned)q3 << 24);
}
constexpr size_t WS_XI8 = WS_K;
constexpr size_t WS_SX = WS_SC8 + 128 * 1024;
constexpr size_t WS_RSTD = WS_SC8 + 192 * 1024;
__device__ __forceinline__ void rms2_rows(const Args& A, int lane, int gw, int NGW) {
    unsigned char* XI8 = A.ws + WS_XI8; float* SX = (float*)(A.ws + WS_SX); float* RSTD = (float*)(A.ws + WS_RSTD);
    const bf16_t* X1 = (const bf16_t*)(A.ws + WS_X1);
    f32x4 gv[8];
#pragma unroll
    for (int j = 0; j < 8; ++j) gv[j] = *(const f32x4*)(A.norm2_g + 4 * lane + 256 * j);
    f32x4 nx[8];
    if (gw < T) {
#pragma unroll
        for (int j = 0; j < 8; ++j) { const u32x2 t = *(const u32x2*)(X1 + (size_t)gw * D + 4 * lane + 256 * j); nx[j] = (f32x4){bflo(t.x), bfhi(t.x), bflo(t.y), bfhi(t.y)}; } }
    for (int row = gw; row < T; row += NGW) {
        f32x4 v[8]; float ss = 0.f;
#pragma unroll
        for (int j = 0; j < 8; ++j) { v[j] = nx[j]; ss += (v[j][0] * v[j][0] + v[j][1] * v[j][1]) + (v[j][2] * v[j][2] + v[j][3] * v[j][3]); }
        if (row + NGW < T) {
#pragma unroll
            for (int j = 0; j < 8; ++j) { const u32x2 t = *(const u32x2*)(X1 + (size_t)(row + NGW) * D + 4 * lane + 256 * j); nx[j] = (f32x4){bflo(t.x), bfhi(t.x), bflo(t.y), bfhi(t.y)}; } }
        const float rstd = 1.0f / sqrtf(wave_sum(ss) * (1.0f / D) + EPS);
        float am = 0.f;
#pragma unroll
        for (int j = 0; j < 8; ++j) { v[j] = v[j] * rstd * gv[j]; am = __builtin_fmaxf(__builtin_fmaxf(am, __builtin_fmaxf(__builtin_fabsf(v[j][0]), __builtin_fabsf(v[j][1]))), __builtin_fmaxf(__builtin_fabsf(v[j][2]), __builtin_fabsf(v[j][3]))); }
        am = __builtin_fmaxf(wave_max(am), 1e-30f); const float inv = 127.0f / am;
#pragma unroll
        for (int j = 0; j < 8; ++j) *(unsigned*)(XI8 + (size_t)row * D + 4 * lane + 256 * j) = pack_i8(v[j], inv);
        if (lane == 0) { SX[row] = am * (1.0f / 127.0f); RSTD[row] = rstd; }
    }
}

__device__ __forceinline__ unsigned f2ord(float f) { const unsigned u = __float_as_uint(f); return u ^ ((u >> 31) ? 0xFFFFFFFFu : 0x80000000u); }
__device__ __forceinline__ float ord2f(unsigned k) { const unsigned u = (k & 0x80000000u) ? (k ^ 0x80000000u) : ~k; return __uint_as_float(u); }
#define INS16(L, xin) do { unsigned _x = (xin); _Pragma("unroll") for (int _i = 0; _i < 16; ++_i) { const unsigned _hi = max(L[_i], _x); _x = min(L[_i], _x); L[_i] = _hi; } } while (0)

#define CE16(i, j) do { const unsigned x_ = a[i], y_ = a[j]; a[i] = max(x_, y_); a[j] = min(x_, y_); } while (0)
__device__ __forceinline__ void bsort16(unsigned (&a)[16]) {
    CE16(0, 13); CE16(1, 12); CE16(2, 15); CE16(3, 14); CE16(4, 8); CE16(5, 6); CE16(7, 11); CE16(9, 10);
    CE16(0, 5); CE16(1, 7); CE16(2, 9); CE16(3, 4); CE16(6, 13); CE16(8, 14); CE16(10, 15); CE16(11, 12);
    CE16(0, 1); CE16(2, 3); CE16(4, 5); CE16(6, 8); CE16(7, 9); CE16(10, 11); CE16(12, 13); CE16(14, 15);
    CE16(0, 2); CE16(1, 3); CE16(4, 10); CE16(5, 11); CE16(6, 7); CE16(8, 9); CE16(12, 14); CE16(13, 15);
    CE16(1, 2); CE16(3, 12); CE16(4, 6); CE16(5, 7); CE16(8, 10); CE16(9, 11); CE16(13, 14);
    CE16(1, 4); CE16(2, 6); CE16(5, 8); CE16(7, 10); CE16(9, 13); CE16(11, 14);
    CE16(2, 4); CE16(3, 6); CE16(9, 12); CE16(11, 13);
    CE16(3, 5); CE16(6, 8); CE16(7, 9); CE16(10, 12);
    CE16(3, 4); CE16(5, 6); CE16(7, 8); CE16(9, 10); CE16(11, 12);
    CE16(6, 7); CE16(8, 9);
}
#undef CE16
__device__ __forceinline__ void bmerge16(unsigned (&a)[16], const unsigned (&b)[16]) {
#pragma unroll
    for (int i = 0; i < 16; ++i) a[i] = max(a[i], b[15 - i]);
#pragma unroll
    for (int st = 8; st >= 1; st >>= 1)
#pragma unroll
        for (int i = 0; i < 16; ++i) if ((i & st) == 0) { const unsigned x = a[i], y = a[i + st]; a[i] = max(x, y); a[i + st] = min(x, y); }
}
__device__ __forceinline__ void topk_stage_keys(const Args& A, LAS unsigned char* lds, int h, int wave, int lane) {
    const bf16_t* KEYS = (const bf16_t*)(A.ws + WS_KEYS) + (size_t)h * 2 * 128 * 128;
    __syncthreads();
#pragma unroll
    for (int ii = 0; ii < 8; ++ii) { const int i = 8 * wave + ii, row = 4 * i + (lane >> 4), slot = lane & 15;
        GLDS16(KEYS + (size_t)row * 128 + 8 * (slot ^ (row & 15)), lds + i * 1024); }
    VM_WAIT(); __syncthreads();
}
__device__ __forceinline__ void topk_unit(const Args& A, LAS unsigned char* lds, int unit, int lane, int wave) {
    unsigned char* ws = A.ws;
    const bf16_t* PQ = (const bf16_t*)(ws + WS_XN);
    int* EXPI = (int*)(ws + WS_EXP); float* GATE = (float*)(ws + WS_GATE);
    const int h = unit & 7, tg = unit >> 3, t0 = tg * 32, tl = lane & 31, hh = lane >> 5;
    LAS unsigned* lw = (LAS unsigned*)(lds + 65536 + wave * 8192);
    const float rtok = ((const float*)(ws + WS_RSTD))[t0 + tl];
    unsigned L0[16], L1[16];
#pragma unroll
    for (int p = 0; p < 2; ++p) {
        f32x16 acc[4];
#pragma unroll
        for (int nb = 0; nb < 4; ++nb)
#pragma unroll
            for (int e = 0; e < 16; ++e) acc[nb][e] = 0.f;
        bf16x8 bqv[8];
#pragma unroll
        for (int ks = 0; ks < 8; ++ks) bqv[ks] = *(const bf16x8*)((const unsigned char*)PQ + ((size_t)(((tg * 8 + h) * 2 + p) * 8 + ks)) * 1024 + lane * 16);
#pragma unroll
        for (int ks = 0; ks < 8; ++ks) { const bf16x8 bq = bqv[ks];
#pragma unroll
            for (int nb = 0; nb < 4; ++nb) { const bf16x8 ak = *(const LAS bf16x8*)(lds + p * 32768 + (32 * nb + tl) * 256 + 16 * ((2 * ks + hh) ^ (tl & 15)));
                acc[nb] = __builtin_amdgcn_mfma_f32_32x32x16_bf16(ak, bq, acc[nb], 0, 0, 0); } }
        unsigned L[16], G1[16];
#pragma unroll
        for (int nb = 0; nb < 4; ++nb) { unsigned Gn[16];
#pragma unroll
            for (int e = 0; e < 16; ++e) { const unsigned n = 32 * nb + (e & 3) + 8 * (e >> 2) + 4 * hh; Gn[e] = (f2ord(acc[nb][e] * rtok) & ~127u) | (127u - n); }
            bsort16(Gn);
            if (nb == 0) {
#pragma unroll
                for (int i = 0; i < 16; ++i) L[i] = Gn[i]; }
            else bmerge16(L, Gn); }
#pragma unroll
        for (int i = 0; i < 16; ++i) G1[i] = (unsigned)__shfl_xor(L[i], 32);
        bmerge16(L, G1);
#pragma unroll
        for (int i = 0; i < 16; ++i) { if (p == 0) L0[i] = L[i]; else L1[i] = L[i]; }
    }
    float v0[16], v1[16];
#pragma unroll
    for (int i = 0; i < 16; ++i) { v0[i] = ord2f(L0[i] & ~127u); v1[i] = ord2f(L1[i] & ~127u); lw[i * 64 + lane] = 127u - (L0[i] & 127u); lw[(16 + i) * 64 + lane] = 127u - (L1[i] & 127u); }
    unsigned Cn[16];
    { unsigned CC[64]; int cnt = 0;
#pragma unroll
        for (int i = 0; i < 16; ++i)
#pragma unroll
            for (int j = 0; j < 16; ++j) if ((i + 1) * (j + 1) <= 16) { CC[cnt] = (f2ord(v0[i] + v1[j]) & ~255u) | (255u - (unsigned)(i * 16 + j)); ++cnt; }
#pragma unroll
        for (int i = 50; i < 64; ++i) CC[i] = 0u;
#pragma unroll
        for (int gq = 0; gq < 4; ++gq) { unsigned Gn[16];
#pragma unroll
            for (int e = 0; e < 16; ++e) Gn[e] = CC[16 * gq + e];
            bsort16(Gn);
            if (gq == 0) {
#pragma unroll
                for (int i = 0; i < 16; ++i) Cn[i] = Gn[i]; }
            else bmerge16(Cn, Gn); } }
    float cv[16]; float sum = 0.f;
    const float m0 = ord2f(Cn[0] & ~255u);
#pragma unroll
    for (int rr = 0; rr < 16; ++rr) { cv[rr] = __expf(ord2f(Cn[rr] & ~255u) - m0); sum += cv[rr]; }
    const float rs = 1.0f / sum;
    if (hh == 0) {
        const size_t o = (size_t)(t0 + tl) * 128 + h * 16;
#pragma unroll
        for (int rr = 0; rr < 16; ++rr) { const unsigned code = 255u - (Cn[rr] & 255u), i = code >> 4, j = code & 15u;
            const unsigned e1 = lw[i * 64 + lane], e2 = lw[(16 + j) * 64 + lane];
            EXPI[o + rr] = (int)(e1 * 128u + e2); GATE[o + rr] = cv[rr] * rs; }
    }
}

__device__ __forceinline__ float gelu_erf(float v) { return 0.5f * v * (1.0f + erff(v * 0.70710678118654752f)); }
constexpr int P11_LW = 13312, P11_IDS = 512, P11_GT = 4608, P11_DOT = 8704;
__device__ __forceinline__ void convert_i8_rows(const float* src, unsigned char* dst, float* sc, int gw, int NGW, int lane) {
    for (int row = gw; row < 16384; row += NGW) {
        const float* s = src + (size_t)row * D + 4 * lane;
        f32x4 v[8]; float am = 0.f;
#pragma unroll
        for (int j = 0; j < 8; ++j) { v[j] = *(const f32x4*)(s + 256 * j);
            am = __builtin_fmaxf(__builtin_fmaxf(am, __builtin_fmaxf(__builtin_fabsf(v[j][0]), __builtin_fabsf(v[j][1]))), __builtin_fmaxf(__builtin_fabsf(v[j][2]), __builtin_fabsf(v[j][3]))); }
        am = __builtin_fmaxf(wave_max(am), 1e-30f);
        const float inv = 127.0f / am;
#pragma unroll
        for (int j = 0; j < 8; ++j) *(unsigned*)(dst + (size_t)row * D + 4 * lane + 256 * j) = pack_i8(v[j], inv);
        if (lane == 0) sc[row] = am * (1.0f / 127.0f);
    }
}
constexpr int F6_ROWB = 1536;
constexpr size_t WS_SCV = WS_SC8 + 64 * 1024;
__device__ __forceinline__ float f6_mag(int c) { return c < 16 ? 0.125f * (float)c : c < 24 ? 2.0f + 0.25f * (float)(c - 16) : 4.0f + 0.5f * (float)(c - 24); }
__device__ __forceinline__ void convert_fp6_rows(const float* src, unsigned char* dst, float* sc, LAS float* scr, int gw, int NGW, int lane) {
    LAS int* tab = (LAS int*)(scr + 64 * 36);
    int cfs[32];
    { f32x16v ta, tb;
#pragma unroll
      for (int i = 0; i < 16; ++i) { ta[i] = f6_mag(i); tb[i] = f6_mag(16 + i); }
      asm volatile("" : "+v"(ta), "+v"(tb));
      const u32x6 tp = __builtin_amdgcn_cvt_scalef32_2xpk16_fp6_f32(ta, tb, 1.0f);
      const f32x32v tr = __builtin_amdgcn_cvt_scalef32_pk32_f32_fp6(tp, 1.0f);
#pragma unroll
      for (int k = 0; k < 32; ++k) { const float y = tr[k]; const int sidx = (int)(y < 2.0f ? y * 8.0f : y < 4.0f ? 16.0f + (y - 2.0f) * 4.0f : 24.0f + (y - 4.0f) * 2.0f) & 31; if (lane == 0) tab[sidx] = k; }
#pragma unroll
      for (int q = 0; q < 32; ++q) cfs[q] = tab[q]; }
    const int slot = (lane >> 1) & 7, half = lane & 1;
    const int off16 = 384 * (lane >> 4) + (half ? 256 : 0) + 16 * slot, off8 = 384 * (lane >> 4) + 128 + 16 * slot + (half ? 8 : 0);
    for (int row = gw; row < 16384; row += NGW) {
        const float* s = src + (size_t)row * D;
#pragma unroll
        for (int j = 0; j < 8; ++j) { const int c = 4 * lane + 256 * j; *(LAS f32x4*)(scr + 36 * (c >> 5) + (c & 31)) = *(const f32x4*)(s + c); }
        float v[32]; float am = 0.f;
#pragma unroll
        for (int q = 0; q < 32; ++q) { v[q] = scr[36 * lane + cfs[q]]; am = __builtin_fmaxf(am, __builtin_fabsf(v[q])); }
        am = __builtin_fmaxf(wave_max(am), 1e-30f);
        const float inv = 7.5f / am;
        f32x16v a, b;
#pragma unroll
        for (int i = 0; i < 16; ++i) { a[i] = v[i] * inv; b[i] = v[16 + i] * inv; }
        const u32x6 p = __builtin_amdgcn_cvt_scalef32_2xpk16_fp6_f32(a, b, 1.0f);
        unsigned char* d = dst + (size_t)row * F6_ROWB;
        *(u32x4*)(d + off16) = half ? (u32x4){p[2], p[3], p[4], p[5]} : (u32x4){p[0], p[1], p[2], p[3]};
        *(u32x2*)(d + off8) = half ? (u32x2){p[0], p[1]} : (u32x2){p[4], p[5]};
        if (lane == 0) sc[row] = am * (1.0f / 7.5f);
    }
}
__device__ __forceinline__ void ld_quad8(u32x4 (&r)[4][2], const unsigned char* TAB, const u32x4 ids, unsigned colb) {
#pragma unroll
    for (int e = 0; e < 4; ++e) { const unsigned char* p = TAB + (ids[e] * (unsigned)D + colb);
        r[e][0] = *(const u32x4*)p; r[e][1] = *(const u32x4*)(p + 128); }
}
__device__ __forceinline__ void gather_lanes8(const Args& A, LAS unsigned char* ldsw, int lane, int gw, int NGW) {
    unsigned char* ws = A.ws;
    const unsigned char *PU = ws + WS_KT, *PV = ws + WS_VT, *XI8 = ws + WS_XI8; const float *SCU = (const float*)(ws + WS_SC8), *SX = (const float*)(ws + WS_SX), *SCV = (const float*)(ws + WS_SCV);
    const int* EXPI = (const int*)(ws + WS_EXP); const float* GATE = (const float*)(ws + WS_GATE);
    LAS unsigned* KEY = (LAS unsigned*)ldsw; LAS unsigned* IDS = (LAS unsigned*)(ldsw + P11_IDS); LAS float* GT = (LAS float*)(ldsw + P11_GT); LAS int* DOT = (LAS int*)(ldsw + P11_DOT);
    const int tj = lane >> 3, l8 = lane & 7;
    const int el4 = ((lane & 1) << 1) | ((lane & 2) >> 1);
    for (int tb = gw * 8; tb < T; tb += NGW * 8) {
        unsigned idA[8], idB[8]; float gA[8], gB[8];
#pragma unroll
        for (int i = 0; i < 8; ++i) { const size_t o = (size_t)(tb + i) * 128; idA[i] = (unsigned)EXPI[o + lane]; idB[i] = (unsigned)EXPI[o + 64 + lane]; gA[i] = GATE[o + lane]; gB[i] = GATE[o + 64 + lane]; }
#pragma unroll
        for (int i = 0; i < 8; ++i) { const unsigned ida = idA[i], idb = idB[i]; const float ga = gA[i], gb = gB[i];
            const unsigned ka = (ida << 7) | (unsigned)lane, kb = (idb << 7) | (unsigned)(64 + lane);
            KEY[lane] = ka; KEY[64 + lane] = kb;
            unsigned ra = 0, rb = 0;
#pragma unroll 4
            for (int j4 = 0; j4 < 32; ++j4) { const u32x4 kk = *(const LAS u32x4*)(KEY + 4 * j4);
#pragma unroll
                for (int q = 0; q < 4; ++q) { const unsigned kv = kk[q]; ra += (kv < ka) ? 1u : 0u; rb += (kv < kb) ? 1u : 0u; } }
            IDS[i * 128 + ra] = ida; GT[i * 128 + ra] = ga; IDS[i * 128 + rb] = idb; GT[i * 128 + rb] = gb;
            DOT[i * 128 + lane] = 0; DOT[i * 128 + 64 + lane] = 0; }
        const LAS unsigned* myids = IDS + tj * 128; LAS int* mydot = DOT + tj * 128; const LAS float* myact = GT + tj * 128;
        const size_t trow = (size_t)(tb + tj) * D;
        u32x4 xnx[2];
#pragma unroll
        for (int c = 0; c < 2; ++c) xnx[c] = *(const u32x4*)(XI8 + trow + 16u * l8 + 128 * c);
#pragma unroll 1
        for (int sw = 0; sw < 8; ++sw) { const unsigned colb = 256u * sw + 16u * l8;
            u32x4 xi[2];
#pragma unroll
            for (int c = 0; c < 2; ++c) { xi[c] = xnx[c]; xnx[c] = *(const u32x4*)(XI8 + trow + ((colb + 256u) & 2047u) + 128 * c); }
            u32x4 r0_[4][2], r1_[4][2], r2_[4][2], r3_[4][2];
            ld_quad8(r0_, PU, *(const LAS u32x4*)(myids), colb); ld_quad8(r1_, PU, *(const LAS u32x4*)(myids + 4), colb); ld_quad8(r2_, PU, *(const LAS u32x4*)(myids + 8), colb);
#define U8_COMPUTE(R, Q) do { int part[4]; \
            _Pragma("unroll") for (int e = 0; e < 4; ++e) { int a1 = 0; \
                _Pragma("unroll") for (int c = 0; c < 2; ++c) _Pragma("unroll") for (int w = 0; w < 4; ++w) a1 = __builtin_amdgcn_sdot4((int)R[e][c][w], (int)xi[c][w], a1, false); \
                part[e] = a1; } \
            _Pragma("unroll") for (int q2 = 0; q2 < 2; ++q2) { const int send = (lane & 1) ? part[q2] : part[q2 + 2], keep = (lane & 1) ? part[q2 + 2] : part[q2]; part[q2] = keep + __shfl_xor(send, 1); } \
            { const int send = (lane & 2) ? part[0] : part[1], keep = (lane & 2) ? part[1] : part[0]; part[0] = keep + __shfl_xor(send, 2); } \
            int dt = part[0]; dt += __shfl_xor(dt, 4); \
            if (l8 < 4) mydot[4 * (Q) + el4] += dt; } while (0)
#pragma unroll 1
            for (int q = 0; q < 28; q += 4) {
                ld_quad8(r3_, PU, *(const LAS u32x4*)(myids + 4 * (q + 3)), colb);
                U8_COMPUTE(r0_, q);
                ld_quad8(r0_, PU, *(const LAS u32x4*)(myids + 4 * (q + 4)), colb);
                U8_COMPUTE(r1_, q + 1);
                ld_quad8(r1_, PU, *(const LAS u32x4*)(myids + 4 * (q + 5)), colb);
                U8_COMPUTE(r2_, q + 2);
                ld_quad8(r2_, PU, *(const LAS u32x4*)(myids + 4 * (q + 6)), colb);
                U8_COMPUTE(r3_, q + 3);
            }
            ld_quad8(r3_, PU, *(const LAS u32x4*)(myids + 4 * 31), colb);
            U8_COMPUTE(r0_, 28); U8_COMPUTE(r1_, 29); U8_COMPUTE(r2_, 30); U8_COMPUTE(r3_, 31);
#undef U8_COMPUTE
        }
        { float su0[8], su1[8], sv0[8], sv1[8], sx8[8];
#pragma unroll
          for (int i = 0; i < 8; ++i) { const unsigned id0 = IDS[i * 128 + lane], id1 = IDS[i * 128 + 64 + lane]; su0[i] = SCU[id0]; su1[i] = SCU[id1]; sv0[i] = SCV[id0]; sv1[i] = SCV[id1]; sx8[i] = SX[tb + i]; }
#pragma unroll
          for (int i = 0; i < 8; ++i) { const float d0 = (float)DOT[i * 128 + lane] * (su0[i] * sx8[i]), d1 = (float)DOT[i * 128 + 64 + lane] * (su1[i] * sx8[i]);
            GT[i * 128 + lane] = gelu_erf(d0) * GT[i * 128 + lane] * sv0[i]; GT[i * 128 + 64 + lane] = gelu_erf(d1) * GT[i * 128 + 64 + lane] * sv1[i]; } }
#pragma unroll 1
        for (int sw = 0; sw < 4; ++sw) { const unsigned ofs = 384u * sw + 16u * l8; const int colb = 512 * sw + 64 * l8;
            f32x2v acc[32];
#pragma unroll
            for (int c = 0; c < 32; ++c) acc[c] = (f32x2v){0.f, 0.f};
            u32x4 r0_[2][3], r1_[2][3], r2_[2][3];
#define V6_LOAD(R, Q) do { const u32x2 id2 = *(const LAS u32x2*)(myids + 2 * (Q)); \
            _Pragma("unroll") for (int e = 0; e < 2; ++e) { const unsigned char* p = PV + (id2[e] * (unsigned)F6_ROWB + ofs); \
                R[e][0] = *(const u32x4*)p; R[e][1] = *(const u32x4*)(p + 128); R[e][2] = *(const u32x4*)(p + 256); } } while (0)
#define V6_COMPUTE(R, Q) do { const f32x2v av = *(const LAS f32x2v*)(myact + 2 * (Q)); \
            _Pragma("unroll") for (int e = 0; e < 2; ++e) { const float a = av[e]; \
                { const f32x32v ra = __builtin_amdgcn_cvt_scalef32_pk32_f32_fp6((u32x6){R[e][0][0], R[e][0][1], R[e][0][2], R[e][0][3], R[e][1][0], R[e][1][1]}, 1.0f); \
                  _Pragma("unroll") for (int i = 0; i < 16; ++i) acc[i] += (f32x2v){ra[2 * i], ra[2 * i + 1]} * a; } \
                { const f32x32v rb = __builtin_amdgcn_cvt_scalef32_pk32_f32_fp6((u32x6){R[e][1][2], R[e][1][3], R[e][2][0], R[e][2][1], R[e][2][2], R[e][2][3]}, 1.0f); \
                  _Pragma("unroll") for (int i = 0; i < 16; ++i) acc[16 + i] += (f32x2v){rb[2 * i], rb[2 * i + 1]} * a; } } } while (0)
            V6_LOAD(r0_, 0); V6_LOAD(r1_, 1);
#pragma unroll 1
            for (int q = 0; q < 60; q += 3) {
                V6_LOAD(r2_, q + 2); V6_COMPUTE(r0_, q);
                V6_LOAD(r0_, q + 3); V6_COMPUTE(r1_, q + 1);
                V6_LOAD(r1_, q + 4); V6_COMPUTE(r2_, q + 2);
            }
            V6_LOAD(r2_, 62); V6_COMPUTE(r0_, 60);
            V6_LOAD(r0_, 63); V6_COMPUTE(r1_, 61);
            V6_COMPUTE(r2_, 62); V6_COMPUTE(r0_, 63);
#undef V6_LOAD
#undef V6_COMPUTE
            { u32x2 x1v[16];
#pragma unroll
              for (int q4 = 0; q4 < 16; ++q4) x1v[q4] = *(const u32x2*)((const bf16_t*)(ws + WS_X1) + trow + colb + 4 * q4);
#pragma unroll
              for (int q4 = 0; q4 < 16; ++q4) { f32x4 a = {bflo(x1v[q4].x), bfhi(x1v[q4].x), bflo(x1v[q4].y), bfhi(x1v[q4].y)};
                a[0] += acc[2 * q4][0]; a[1] += acc[2 * q4][1]; a[2] += acc[2 * q4 + 1][0]; a[3] += acc[2 * q4 + 1][1];
                *(f32x4*)(A.out + trow + colb + 4 * q4) = a; } }
        }
    }
}
__global__ void __launch_bounds__(NTHR, 2) fwd_kernel(Args A) {
    extern __shared__ __attribute__((aligned(16))) unsigned char lds_raw[];
    LAS unsigned char* lds = (LAS unsigned char*)lds_raw;
    const int tid = threadIdx.x, lane = tid & 63, wave = __builtin_amdgcn_readfirstlane(tid >> 6);
    const int G = gridDim.x, bx = blockIdx.x;
    const int vcu = (G % 8 == 0) ? (bx % 8) * (G / 8) + bx / 8 : bx;
    const int gw = bx * NWAVES + wave, NGW = G * NWAVES;
    unsigned char* ws = A.ws;
    volatile LAS unsigned* MISC = (volatile LAS unsigned*)(lds + MISC_OFF);
    if (tid < 16) MISC[tid] = 0u;
    __syncthreads();
    const int lo = A.ph_lo, hi = A.ph_hi;
    XcdBarrier bar; bar.bar = (unsigned*)(ws + WS_CTL) + CW_BAR; bar.x = 0; bar.st = nullptr;
    if (hi - lo > 1) bar = xcd_barrier_post((unsigned*)(ws + WS_CTL) + CW_BAR, MISC + 8);
#ifndef ONLY_PHASE
#define ONLY_PHASE -1
#endif
#define IN(k) ((ONLY_PHASE < 0 || ONLY_PHASE == (k)) && lo <= (k) && (k) < hi)
#define SEAM(k) do { if (IN(k) && IN((k) + 1)) xcd_barrier(bar); } while (0)

    if (IN(0)) { p0_prologue(A, lds, tid, lane, wave, G); }
    SEAM(0);
    if (IN(1)) {
        if (bx < 32) gate_scan(A, lds, bx, tid, lane, wave);
        EpiInProj E{ws, (bf16_t*)A.out, 0, 1.0f};
        { pg8::Gemm g{(const bf16_t*)(ws + WS_XN), (const bf16_t*)(ws + WS_WIN16), T, N16, D}; pg8::StaticOrder S; S.init(T, N16, G, bx);
          pg8::gemm_phase<EpiInProj, pg8::StaticOrder, false, false>(lds, g, S, E, nullptr); }
        E.pn0 = N16 / 256; E.osc = IN_FP6 ? 1.0f : 1.0f / (XN8_SCALE * WIN8_SCALE);
        { pg8::Gemm g{(const bf16_t*)(ws + WS_XN8), (const bf16_t*)(ws + WS_WIN8), T, 15360 - N16, D / 2}; pg8::StaticOrder S; S.init(T, 15360 - N16, G, bx);
          pg8::gemm_phase<EpiInProj, pg8::StaticOrder, false, true, (IN_FP6 != 0)>(lds, g, S, E, nullptr);
#ifdef DBG_F8TWICE
          pg8::gemm_phase<EpiInProj, pg8::StaticOrder, false, true>(lds, g, S, E, nullptr);
#endif
          }
    }
    SEAM(1);
    if (IN(2)) {
        attn_phase(A, lds, vcu, G, tid, lane, wave);
#ifdef DBG_ATT2
        attn_phase(A, lds, vcu, G, tid, lane, wave);
#endif
        for (int u = vcu; u < 1024; u += G) ss_unit(A, lds, u, lane, wave);
#ifdef DBG_SS2
        for (int u = vcu; u < 1024; u += G) ss_unit(A, lds, u, lane, wave);
#endif
        __syncthreads();
        LAS float* scr = (LAS float*)(lds + wave * 8704);
        constexpr int NBLK = D / 32, NIT = (D / 64) * NBLK;
        for (int it = gw; it < 4 * NIT; it += NGW) { const int w = it / NIT, r = it % NIT;
            if (w < 2 || (P6_FP8 && w == 2)) transpose_item8<false>(w == 0 ? A.w_a : w == 1 ? A.w_m : A.w_out, D, D, NBLK, ws + (w == 0 ? WS_WA : w == 1 ? WS_WM : WS_WO), scr, r, lane);
            else transpose_item(w == 2 ? A.w_out : A.peer_wq, D, D, NBLK, (bf16_t*)(ws + (w == 2 ? WS_WO : WS_WQ)), scr, r, lane, false, w == 3 ? A.norm2_g : nullptr); }
        convert_stream(A.peer_keys, (bf16_t*)(ws + WS_KEYS), (size_t)16 * 128 * 128, bx * NTHR + tid, G * NTHR);
    }
    SEAM(2);
    if (IN(3)) {
        if (wave == 0) for (int idx = bx * 64 + lane; idx < 32 * 512; idx += G * 64) mlstm_nscan(A, idx);
        for (int u = vcu; u < 256; u += G) mlstm_unit(A, lds, u, tid, lane, wave);
    }
    SEAM(3);
    if (IN(4)) {
        hm_rows(A, lane, gw, NGW);
        convert_fp6_rows(A.peer_v, ws + WS_VT, (float*)(ws + WS_SCV), (LAS float*)(lds + wave * 9472), gw, NGW, lane);
    }
    SEAM(4);
    if (IN(5)) {
        pg8::StaticOrder S; S.init(T, D, G, bx);
        { pg8::Gemm g{(const bf16_t*)(ws + WS_HA8), (const bf16_t*)(ws + WS_WA), T, D, D / 2, (const bf16_t*)(ws + WS_HM8), (const bf16_t*)(ws + WS_WM)};
          EpiMerge2 E{(const bf16_t*)A.out + (size_t)T * D, (const bf16_t*)A.out, (bf16_t*)(ws + WS_SO), (P6_FP8 ? H8_SCALE : 1.0f) / (H8_SCALE * WIN8_SCALE)};
          pg8::gemm_phase<EpiMerge2, pg8::StaticOrder, false, true>(lds, g, S, E, nullptr); }
    }
    SEAM(5);
    if (IN(6)) {
        pg8::StaticOrder S; S.init(T, D, G, bx);
#if P6_FP8
        pg8::Gemm g{(const bf16_t*)(ws + WS_SO), (const bf16_t*)(ws + WS_WO), T, D, D / 2}; EpiResid E{A.x, (bf16_t*)(ws + WS_X1), 1.0f / (H8_SCALE * WIN8_SCALE)};
        pg8::gemm_phase<EpiResid, pg8::StaticOrder, false, true>(lds, g, S, E, nullptr);
#else
        pg8::Gemm g{(const bf16_t*)(ws + WS_SO), (const bf16_t*)(ws + WS_WO), T, D, D}; EpiResid E{A.x, (bf16_t*)(ws + WS_X1), 1.0f};
        pg8::gemm_phase<EpiResid, pg8::StaticOrder, false, false>(lds, g, S, E, nullptr);
#endif
    }
    SEAM(6);
    if (IN(7)) { rms2_rows(A, lane, gw, NGW); }
    if (IN(8)) {
        pg8::StaticOrder S; S.init(T, D, G, bx);
        pg8::Gemm g{(const bf16_t*)(ws + WS_X1), (const bf16_t*)(ws + WS_WQ), T, D, D}; EpiPlainBf16 E{(bf16_t*)(ws + WS_XN)};
        pg8::gemm_phase<EpiPlainBf16, pg8::StaticOrder, false>(lds, g, S, E, nullptr);
    }
    SEAM(8);
    if (IN(9)) {
        if (G % 8 == 0) { const int h = bx & 7; topk_stage_keys(A, lds, h, wave, lane);
            if (wave < 4) convert_i8_rows(A.peer_u, ws + WS_KT, (float*)(ws + WS_SC8), gw, NGW, lane);
            for (int tg = (bx >> 3) * NWAVES + wave; tg < 512; tg += (G >> 3) * NWAVES) topk_unit(A, lds, tg * 8 + h, lane, wave);
            if (wave >= 4) convert_i8_rows(A.peer_u, ws + WS_KT, (float*)(ws + WS_SC8), gw, NGW, lane); }
        else { convert_i8_rows(A.peer_u, ws + WS_KT, (float*)(ws + WS_SC8), gw, NGW, lane);
            for (int h = 0; h < 8; ++h) { topk_stage_keys(A, lds, h, wave, lane);
            for (int tg = gw; tg < 512; tg += NGW) topk_unit(A, lds, tg * 8 + h, lane, wave); } }
        __syncthreads();
    }
    SEAM(9);
    if (IN(10)) { gather_lanes8(A, lds + wave * P11_LW, lane, gw, NGW); }
}

#ifndef N_LAUNCHES
#define N_LAUNCHES 1
#endif
extern "C" void kernel_launch(void* const* d_in, const int* in_sizes, int n_in, void* d_out, int out_size, void* d_ws, size_t ws_size, hipStream_t stream) {
    static int grid = 0;
    if (grid == 0) {
        if (n_in != 17 || in_sizes[0] != T * D || out_size != T * D || ws_size < WS_END) { fprintf(stderr, "kernel_launch: unexpected shapes (n_in %d, in0 %d, out %d, ws %zu): nothing launched\n", n_in, n_in > 0 ? in_sizes[0] : -1, out_size, ws_size); grid = -1; return; }
        int dev = 0, cus = 0, per_cu = 0;
        if (hipGetDevice(&dev) != hipSuccess || hipDeviceGetAttribute(&cus, hipDeviceAttributeMultiprocessorCount, dev) != hipSuccess) { grid = -1; return; }
        if (hipFuncSetAttribute((const void*)fwd_kernel, hipFuncAttributeMaxDynamicSharedMemorySize, LDS_BYTES) != hipSuccess) { fprintf(stderr, "kernel_launch: hipFuncSetAttribute failed\n"); grid = -1; return; }
        if (hipOccupancyMaxActiveBlocksPerMultiprocessor(&per_cu, (const void*)fwd_kernel, NTHR, LDS_BYTES) != hipSuccess || per_cu < 1) { fprintf(stderr, "kernel_launch: occupancy query reports %d\n", per_cu); }
        (void)hipGetLastError();
        grid = cus;
    }
    if (grid < 0) return;
    if (hipMemsetAsync((char*)d_ws + WS_CTL, 0, CTL_ZERO_BYTES, stream) != hipSuccess) return;
    Args a{};
    a.x = (const float*)d_in[0]; a.norm1_g = (const float*)d_in[1]; a.w_in = (const float*)d_in[2]; a.gate_b = (const float*)d_in[3]; a.mnorm_g = (const float*)d_in[4]; a.w_m = (const float*)d_in[5];
    a.gq = (const float*)d_in[6]; a.gk = (const float*)d_in[7]; a.sink = (const float*)d_in[8]; a.rel_bias = (const float*)d_in[9]; a.w_a = (const float*)d_in[10]; a.w_out = (const float*)d_in[11];
    a.norm2_g = (const float*)d_in[12]; a.peer_wq = (const float*)d_in[13]; a.peer_keys = (const float*)d_in[14]; a.peer_u = (const float*)d_in[15]; a.peer_v = (const float*)d_in[16];
    a.out = (float*)d_out; a.ws = (unsigned char*)d_ws;
#ifndef DBG_LAST
#define DBG_LAST (NPHASE - 1)
#endif
#ifndef DBG_REPEAT
#define DBG_REPEAT -1
#endif
    for (int li = 0; li < N_LAUNCHES && li <= DBG_LAST; ++li) {
        a.ph_lo = (N_LAUNCHES == 1) ? 0 : li; a.ph_hi = (N_LAUNCHES == 1) ? NPHASE : li + 1;
        hipLaunchKernelGGL(fwd_kernel, dim3(grid), dim3(NTHR), LDS_BYTES, stream, a);
        if (N_LAUNCHES > 1 && DBG_REPEAT >= 0 && DBG_REPEAT < 10 && li == DBG_REPEAT) hipLaunchKernelGGL(fwd_kernel, dim3(grid), dim3(NTHR), LDS_BYTES, stream, a);
        if (N_LAUNCHES > 1 && DBG_REPEAT == 10 && li == 10) for (int k = 6; k <= 10; ++k) { a.ph_lo = k; a.ph_hi = k + 1; hipLaunchKernelGGL(fwd_kernel, dim3(grid), dim3(NTHR), LDS_BYTES, stream, a); }
    }
}
```
